# Optimizing an MI355X kernel written in HIP

```python
import math
import jax, jax.numpy as jnp
from jax import lax
import numpy as np

D_MODEL = 2048
BATCH = 1
SEQ = 8192
DEPTH = 1

HEAD_DIM = 128
NA_HEADS = (D_MODEL // 2) // HEAD_DIM
ATTN_WIDTH = NA_HEADS * HEAD_DIM
CONV_WIDTH = D_MODEL - ATTN_WIDTH
CONV_GROUPS = CONV_WIDTH // HEAD_DIM
CONV_K = 3
GRID_W = 64
NA_KH_MAX = 8
NA_KW = 16
N_EXPERTS = 32
TOP_K = 4
D_FF = D_MODEL
SWIGLU_LIMIT = 7.0
SWIGLU_ALPHA = 1.702
MOE_BLOCK = 128
NORM_EPS = 1e-5
NEG_INF = -1e30

kernel_name = "hybrid_conv_natten_moe_encoder"


def rms_norm(x, w):
    xf = x.astype(jnp.float32)
    y = xf * lax.rsqrt(jnp.mean(xf * xf, axis=-1, keepdims=True) + NORM_EPS)
    return (y * w.astype(jnp.float32)).astype(x.dtype)


def group_rms_norm(x, w, group_size):
    shp = x.shape
    xf = x.astype(jnp.float32).reshape(shp[:-1] + (shp[-1] // group_size, group_size))
    y = xf * lax.rsqrt(jnp.mean(xf * xf, axis=-1, keepdims=True) + NORM_EPS)
    return (y.reshape(shp) * w.astype(jnp.float32)).astype(x.dtype)


def neighbourhood_attention(q, k, v, rel_pos_bias):
    bsz, s, _ = q.shape
    rows = s // GRID_W
    kh = min(NA_KH_MAX, rows)
    to_grid = lambda t: t.reshape(bsz, rows, GRID_W, NA_HEADS, HEAD_DIM)
    qg, kg, vg = to_grid(q), to_grid(k), to_grid(v)

    r = jnp.arange(rows)
    row_start = jnp.clip(r - kh // 2, 0, rows - kh)
    row_idx = row_start[:, None] + jnp.arange(kh)[None, :]
    k_rows = kg[:, row_idx]
    v_rows = vg[:, row_idx]

    c = jnp.arange(GRID_W)
    col_start = jnp.clip(c - NA_KW // 2, 0, GRID_W - NA_KW)
    col_in = (c[None, :] >= col_start[:, None]) & (c[None, :] < col_start[:, None] + NA_KW)

    dr = row_idx - r[:, None] + (NA_KH_MAX - 1)
    dc = jnp.clip(c[None, :] - c[:, None], -(NA_KW - 1), NA_KW - 1) + (NA_KW - 1)
    bias = rel_pos_bias[:, dr[:, None, :, None], dc[None, :, None, :]]

    scale = 1.0 / math.sqrt(HEAD_DIM)
    scores = jnp.einsum('brqhd,brikhd->bhrqik', qg, k_rows).astype(jnp.float32) * scale
    scores = scores + bias.astype(jnp.float32)[None]
    scores = jnp.where(col_in[:, None, :], scores, NEG_INF)
    p = jax.nn.softmax(scores, axis=(-2, -1))
    out = jnp.einsum('bhrqik,brikhd->brqhd', p.astype(v.dtype), v_rows)
    return out.reshape(bsz, s, ATTN_WIDTH)


def short_gated_conv(u, gate_b, gate_c, conv_w):
    s = u.shape[1]
    z = gate_c * u
    pad = CONV_K // 2
    zp = jnp.pad(z, ((0, 0), (pad, pad), (0, 0)))
    conv = sum(conv_w[j] * zp[:, j:j + s] for j in range(CONV_K))
    return gate_b * conv


def hybrid_mixer(h, w_in, conv_w, rel_pos_bias, attn_out_norm_w, conv_out_norm_w, w_out):
    proj = h @ w_in
    a, cw = ATTN_WIDTH, CONV_WIDTH
    q, k, v, u, gate_b, gate_c = jnp.split(
        proj, [a, 2 * a, 3 * a, 3 * a + cw, 3 * a + 2 * cw], axis=-1)
    attn = neighbourhood_attention(q, k, v, rel_pos_bias)
    conv = short_gated_conv(u, gate_b, gate_c, conv_w)
    mixed = jnp.concatenate([
        group_rms_norm(attn, attn_out_norm_w, HEAD_DIM),
        group_rms_norm(conv, conv_out_norm_w, CONV_WIDTH // CONV_GROUPS),
    ], axis=-1)
    return mixed @ w_out


def moe_ffn(h, router_w, router_b, w_gate_up, b_gate_up, w_down, b_down):
    t, d = h.shape
    logits = (h @ router_w + router_b).astype(jnp.float32)
    top_logits, top_idx = lax.top_k(logits, TOP_K)
    gates = jax.nn.softmax(top_logits, axis=-1).astype(h.dtype)

    n_assign = t * TOP_K
    flat_e = top_idx.reshape(-1).astype(jnp.int32)
    order = jnp.argsort(flat_e)
    sorted_e = flat_e[order]
    sorted_tok = (order // TOP_K).astype(jnp.int32)
    sorted_gate = gates.reshape(-1)[order]

    counts = jax.ops.segment_sum(jnp.ones_like(flat_e), flat_e, num_segments=N_EXPERTS)
    padded = (counts + MOE_BLOCK - 1) // MOE_BLOCK * MOE_BLOCK
    pad_end = jnp.cumsum(padded)
    pad_start = pad_end - padded
    start = jnp.cumsum(counts) - counts
    dest = pad_start[sorted_e] + jnp.arange(n_assign, dtype=jnp.int32) - start[sorted_e]

    n_blocks = -(-n_assign // MOE_BLOCK) + N_EXPERTS
    n_slots = n_blocks * MOE_BLOCK
    slot_tok = jnp.full((n_slots,), t, jnp.int32).at[dest].set(sorted_tok)
    slot_gate = jnp.zeros((n_slots,), h.dtype).at[dest].set(sorted_gate)
    block_expert = jnp.minimum(
        jnp.searchsorted(pad_end, jnp.arange(n_blocks, dtype=jnp.int32) * MOE_BLOCK, side='right'),
        N_EXPERTS - 1).astype(jnp.int32)

    h_pad = jnp.concatenate([h, jnp.zeros((1, d), h.dtype)], axis=0)
    xb = h_pad[slot_tok].reshape(n_blocks, MOE_BLOCK, d)

    def expert_block(args):
        xblk, e = args
        gu = xblk @ w_gate_up[e] + b_gate_up[e]
        g, lin = jnp.split(gu, 2, axis=-1)
        g = jnp.minimum(g, SWIGLU_LIMIT)
        lin = jnp.clip(lin, -SWIGLU_LIMIT, SWIGLU_LIMIT)
        act = g * jax.nn.sigmoid(SWIGLU_ALPHA * g) * (lin + 1.0)
        return act @ w_down[e] + b_down[e]

    yb = lax.map(expert_block, (xb, block_expert)).reshape(n_slots, d)
    out = jnp.zeros((t + 1, d), h.dtype).at[slot_tok].add(yb * slot_gate[:, None])
    return out[:t]


def setup_inputs(seed: int = 0) -> dict:
    key = jax.random.key(seed)
    ks = jax.random.split(key, 16)
    f32 = jnp.float32
    n_in = 3 * ATTN_WIDTH + 3 * CONV_WIDTH
    nrm = lambda k, shape, s: jax.random.normal(k, shape, f32) * s
    return {
        "x": nrm(ks[0], (BATCH, SEQ, D_MODEL), 1.0),
        "attn_norm_w": 1.0 + nrm(ks[1], (DEPTH, D_MODEL), 0.02),
        "w_in": nrm(ks[2], (DEPTH, D_MODEL, n_in), D_MODEL ** -0.5),
        "conv_w": nrm(ks[3], (DEPTH, CONV_K, CONV_WIDTH), CONV_K ** -0.5),
        "rel_pos_bias": nrm(ks[4], (DEPTH, NA_HEADS, 2 * NA_KH_MAX - 1, 2 * NA_KW - 1), 0.1),
        "attn_out_norm_w": 1.0 + nrm(ks[5], (DEPTH, ATTN_WIDTH), 0.02),
        "conv_out_norm_w": 1.0 + nrm(ks[6], (DEPTH, CONV_WIDTH), 0.02),
        "w_out": nrm(ks[7], (DEPTH, D_MODEL, D_MODEL), D_MODEL ** -0.5),
        "ffn_norm_w": 1.0 + nrm(ks[8], (DEPTH, D_MODEL), 0.02),
        "router_w": nrm(ks[9], (DEPTH, D_MODEL, N_EXPERTS), D_MODEL ** -0.5),
        "router_b": nrm(ks[10], (DEPTH, N_EXPERTS), 0.01),
        "w_gate_up": nrm(ks[11], (DEPTH, N_EXPERTS, D_MODEL, 2 * D_FF), D_MODEL ** -0.5),
        "b_gate_up": nrm(ks[12], (DEPTH, N_EXPERTS, 2 * D_FF), 0.02),
        "w_down": nrm(ks[13], (DEPTH, N_EXPERTS, D_FF, D_MODEL), D_FF ** -0.5),
        "b_down": nrm(ks[14], (DEPTH, N_EXPERTS, D_MODEL), 0.02),
        "final_norm_w": 1.0 + nrm(ks[15], (D_MODEL,), 0.02),
    }


def reference(x, attn_norm_w, w_in, conv_w, rel_pos_bias, attn_out_norm_w, conv_out_norm_w,
              w_out, ffn_norm_w, router_w, router_b, w_gate_up, b_gate_up, w_down, b_down,
              final_norm_w):
    bsz, s, d = x.shape
    h = x
    for layer in range(DEPTH):
        h = h + hybrid_mixer(rms_norm(h, attn_norm_w[layer]), w_in[layer], conv_w[layer],
                             rel_pos_bias[layer], attn_out_norm_w[layer],
                             conv_out_norm_w[layer], w_out[layer])
        f = moe_ffn(rms_norm(h, ffn_norm_w[layer]).reshape(bsz * s, d), router_w[layer],
                    router_b[layer], w_gate_up[layer], b_gate_up[layer], w_down[layer],
                    b_down[layer])
        h = h + f.reshape(bsz, s, d)
    return rms_norm(h, final_norm_w)
```

```cpp
#include <hip/hip_runtime.h>
#include <cstdio>
#include <cstdint>
namespace pg8 {
#define PG8_LAS __attribute__((address_space(3)))
typedef unsigned short bf16_t;
typedef short bf16x8 __attribute__((ext_vector_type(8)));
typedef float f32x4 __attribute__((ext_vector_type(4)));
typedef unsigned u32x4 __attribute__((ext_vector_type(4)));
constexpr int BM = 256, BK = 64, HALF = 128, HTB = HALF * BK * 2  , STAGE_BYTES = 8 * HTB, NXCD = 8, WGM = 8;

__host__ __device__ __forceinline__ int lds_byte(int r, int c) { const int st = (r >> 4) * 2 + (c >> 5), rr = r & 15, cc = c & 31, ob = rr * 64 + cc * 2; return st * 1024 + (ob ^ (((ob >> 9) & 1) << 5)); }
__host__ __device__ __forceinline__ void stage_rc(int b, int& R, int& C) { const int st = b / 1024, sb = b % 1024, swz = sb ^ (((sb >> 9) & 1) << 5); R = (st >> 1) * 16 + swz / 64; C = (st & 1) * 32 + (swz % 64) / 2; }
__host__ __device__ __forceinline__ int perm32(int rho) { const int n = rho >> 4, i = rho & 15; return 8 * (i >> 2) + 4 * n + (i & 3); }

struct Unit { int pm, pn; };
struct Gemm { const bf16_t* A; const bf16_t* Bt; int M, N, K; };


struct StaticOrder {
    int nM, nN, nwg, G, c;
    __host__ __device__ void init(int M, int N, int G_, int c_) { nM = M / BM; nN = N / BM; nwg = nM * nN; G = G_; c = c_; }
    __host__ __device__ bool next(int i, Unit& u) const {
        const long L = (long)i * G + c; if (L >= nwg) return false;
        int wgid = (int)L; { const int q = nwg / NXCD, r = nwg % NXCD, xcd = wgid % NXCD, off = wgid / NXCD; wgid = (xcd < r ? xcd * (q + 1) : r * (q + 1) + (xcd - r) * q) + off; }
        const int nig = WGM * nN, gid = wgid / nig, fm = gid * WGM, gsz = (nM - fm) < WGM ? (nM - fm) : WGM;
        u.pm = fm + ((wgid % nig) % gsz); u.pn = (wgid % nig) / gsz; return true;
    }
    __device__ __forceinline__ void a_ready(const Unit&) const {}
    __device__ __forceinline__ void done(const Unit&) const {}
};
struct MoeOrder {
    const PG8_LAS int* tb; int npn, G, c;
    __device__ __forceinline__ bool next(int i, Unit& u) const {
        const int L = i * G + c, total = tb[32] * npn; if (L >= total) return false;
        int e = 0;
        for (int k = 1; k < 32; ++k) e = (L >= tb[k] * npn) ? k : e;
        const int t0 = tb[e], mt = tb[e + 1] - t0, r = L - t0 * npn, pnl = r / mt, pml = r - pnl * mt;
        u.pm = __builtin_amdgcn_readfirstlane(t0 + pml); u.pn = __builtin_amdgcn_readfirstlane(e * npn + pnl); return true;
    }
    __device__ __forceinline__ void a_ready(const Unit&) const {}
    __device__ __forceinline__ void done(const Unit&) const {}
};
__device__ __forceinline__ unsigned cvt_pk_bf16(float lo, float hi) { unsigned r; asm volatile("v_cvt_pk_bf16_f32 %0, %1, %2" : "=v"(r) : "v"(lo), "v"(hi)); return r; }
typedef float f32x2 __attribute__((ext_vector_type(2)));
__device__ __forceinline__ f32x2 gelu_pk(f32x2 v) {
    const f32x2 av = __builtin_elementwise_abs(v), d = av * 0.2316418882f + 1.0f;
    f32x2 t; t.x = __builtin_amdgcn_rcpf(d.x); t.y = __builtin_amdgcn_rcpf(d.y);
    f32x2 q = t * 0.5307027145f + (-0.7265760135f); q = q * t + 0.7107068705f; q = q * t + (-0.142248368f); q = q * t + 0.127414796f; q = q * t;
    const f32x2 s = (v * v) * (-0.72134752044f);
    f32x2 e; e.x = __builtin_amdgcn_exp2f(s.x); e.y = __builtin_amdgcn_exp2f(s.y);
    const f32x2 m = v * (q * e), r = v - m;
    f32x2 o; o.x = v.x < 0.f ? m.x : r.x; o.y = v.y < 0.f ? m.y : r.y; return o;
}

template <int ACT  > struct EpiBf16 {
    static constexpr bool PERM = true, AFTER_DRAIN = false; static_assert(ACT == 0 || ACT == 1, "EpiBf16: ACT is 0 (none) or 1 (gelu_pk)");
    bf16_t* O; int ldc; const float* bias; int split_cols; size_t split_stride; float scale0;
    __device__ __forceinline__ void operator()(const f32x4 (&acc)[2][2][4][2], const Unit& u, int wr, int wc, int fr, int fq) const {
        const int row0 = u.pm * BM + wr * 64 + fr; int colt = u.pn * BM; bf16_t* base = O;
        float sc = 1.f; if (split_cols) { const int t = colt / split_cols; base += (size_t)t * split_stride; colt -= t * split_cols; if (t == 0) sc = scale0; }
        const int col0 = colt + wc * 32 + 8 * fq, bcol0 = u.pn * BM + wc * 32 + 8 * fq;
        f32x4 bv[2][2];
#pragma unroll
        for (int bj = 0; bj < 2; ++bj)
#pragma unroll
            for (int n = 0; n < 2; ++n) bv[bj][n] = bias ? *(const f32x4*)(bias + bcol0 + bj * HALF + 4 * n) : (f32x4){0.f, 0.f, 0.f, 0.f};
#pragma unroll
        for (int ai = 0; ai < 2; ++ai)
#pragma unroll
            for (int m = 0; m < 4; ++m) { bf16_t* rowp = base + (size_t)(row0 + ai * HALF + m * 16) * ldc + col0;
#pragma unroll
                for (int bj = 0; bj < 2; ++bj) { f32x4 v0 = acc[ai][bj][m][0] + bv[bj][0], v1 = acc[ai][bj][m][1] + bv[bj][1];
                    if (ACT == 1) { f32x2 a = gelu_pk((f32x2){v0[0], v0[1]}), b = gelu_pk((f32x2){v0[2], v0[3]}), c = gelu_pk((f32x2){v1[0], v1[1]}), d = gelu_pk((f32x2){v1[2], v1[3]});
                        v0 = (f32x4){a.x, a.y, b.x, b.y}; v1 = (f32x4){c.x, c.y, d.x, d.y}; }
                    v0 = v0 * sc; v1 = v1 * sc; u32x4 w; w.x = cvt_pk_bf16(v0[0], v0[1]); w.y = cvt_pk_bf16(v0[2], v0[3]); w.z = cvt_pk_bf16(v1[0], v1[1]); w.w = cvt_pk_bf16(v1[2], v1[3]);
                    *(u32x4*)(rowp + bj * HALF) = w; } }
    }
};


struct EpiRes {
    static constexpr bool PERM = false, AFTER_DRAIN = false;
    const float* base; float* out; int ldc;
    __device__ __forceinline__ void operator()(const f32x4 (&acc)[2][2][4][2], const Unit& u, int wr, int wc, int fr, int fq) const {
        const int row0 = u.pm * BM + wr * 64 + fr, col0 = u.pn * BM + wc * 32 + 4 * fq;
#pragma unroll
        for (int ai = 0; ai < 2; ++ai)
#pragma unroll
            for (int m = 0; m < 4; ++m) { const size_t off = (size_t)(row0 + ai * HALF + m * 16) * ldc + col0;
#pragma unroll
                for (int bj = 0; bj < 2; ++bj)
#pragma unroll
                    for (int n = 0; n < 2; ++n) { const f32x4 bs = *(const f32x4*)(base + off + bj * HALF + n * 16); *(f32x4*)(out + off + bj * HALF + n * 16) = bs + acc[ai][bj][m][n]; }
                asm volatile("" ::: "memory"); }
    }
};
struct EpiSwiglu {
    static constexpr bool PERM = true, AFTER_DRAIN = false;
    bf16_t* O; int ldc; const float* bias;
    __device__ __forceinline__ void operator()(const f32x4 (&acc)[2][2][4][2], const Unit& u, int wr, int wc, int fr, int fq) const {
        const int e = u.pn >> 4, pnl = u.pn & 15;
        const int row0 = u.pm * BM + wr * 64 + fr, col0 = pnl * HALF + wc * 32 + 8 * fq;
        const float* bg = bias + (size_t)e * 4096 + col0;
        const f32x4 bg0 = *(const f32x4*)(bg), bg1 = *(const f32x4*)(bg + 4), bl0 = *(const f32x4*)(bg + 2048), bl1 = *(const f32x4*)(bg + 2048 + 4);
#pragma unroll
        for (int ai = 0; ai < 2; ++ai)
#pragma unroll
            for (int m = 0; m < 4; ++m) { bf16_t* rowp = O + (size_t)(row0 + ai * HALF + m * 16) * ldc + col0;
                f32x4 g0 = acc[ai][0][m][0] + bg0, g1 = acc[ai][0][m][1] + bg1, l0 = acc[ai][1][m][0] + bl0, l1 = acc[ai][1][m][1] + bl1;
                float r[8];
#pragma unroll
                for (int j = 0; j < 8; ++j) { float g = j < 4 ? g0[j & 3] : g1[j & 3], l = j < 4 ? l0[j & 3] : l1[j & 3];
                    g = fminf(g, 7.0f); l = fminf(fmaxf(l, -7.0f), 7.0f);
                    const float sg = __builtin_amdgcn_rcpf(1.0f + __builtin_amdgcn_exp2f(g * (-1.702f * 1.4426950408889634f)));
                    r[j] = g * sg * (l + 1.0f); }
                u32x4 w; w.x = cvt_pk_bf16(r[0], r[1]); w.y = cvt_pk_bf16(r[2], r[3]); w.z = cvt_pk_bf16(r[4], r[5]); w.w = cvt_pk_bf16(r[6], r[7]);
                *(u32x4*)rowp = w; }
    }
};
template <class Epi, class Sched, bool ALIGN_EPI = false, bool SP2 = false>
__device__ __forceinline__ void gemm_phase(PG8_LAS unsigned char* lds, const Gemm g, const Sched& S, const Epi& E) {
    const int tid = threadIdx.x, wid = __builtin_amdgcn_readfirstlane(tid >> 6), lane = tid & 63, wr = wid >> 2, wc = wid & 3, fr = lane & 15, fq = lane >> 4;
    const int K = g.K, nt = K / BK;
    unsigned voffA[2], voffB[2];
#pragma unroll
    for (int i = 0; i < 2; ++i) { int R, C; stage_rc(tid * 16 + i * 8192, R, C); const int Rb = Epi::PERM ? ((R & ~31) + perm32(R & 31)) : R;
        voffA[i] = (unsigned)(R * K + C) * 2u; voffB[i] = (unsigned)(Rb * K + C) * 2u; }
    const size_t kstep = (size_t)(BK * 2);
    const size_t hstep = (size_t)HALF * K * 2;
    const size_t tstep = 2 * hstep;
    const unsigned ldsw = (unsigned)wid * 1024u;
    const int aoff = lds_byte(wr * 64 + fr, fq * 8), boff = lds_byte(wc * 32 + fr, fq * 8);
#define PG8_SA(b, h) (((b) * 2 + (h)) * HTB)
#define PG8_SB(b, h) ((4 + (b) * 2 + (h)) * HTB)
#define PG8_STAGE(bufoff, gbase, voff) do { _Pragma("unroll") for (int _i = 0; _i < 2; ++_i) \
        __builtin_amdgcn_global_load_lds((const unsigned*)((const char*)(gbase) + (voff)[_i]), (PG8_LAS unsigned*)(lds + (bufoff) + ldsw + _i * 8192), 16, 0, 0); } while (0)
#define PG8_LDA(dst, b, h) do { _Pragma("unroll") for (int m = 0; m < 4; ++m) _Pragma("unroll") for (int k = 0; k < 2; ++k) dst[m][k] = *(const PG8_LAS bf16x8*)(lds + PG8_SA(b, h) + aoff + m * 2048 + k * 1024); } while (0)
#define PG8_LDB(dst, b, h) do { _Pragma("unroll") for (int n = 0; n < 2; ++n) _Pragma("unroll") for (int k = 0; k < 2; ++k) dst[n][k] = *(const PG8_LAS bf16x8*)(lds + PG8_SB(b, h) + boff + n * 2048 + k * 1024); } while (0)
#define PG8_MMA(ai, bj, At, Bt) do { __builtin_amdgcn_s_setprio(1); _Pragma("unroll") for (int m = 0; m < 4; ++m) _Pragma("unroll") for (int n = 0; n < 2; ++n) _Pragma("unroll") for (int k = 0; k < 2; ++k) \
        acc[ai][bj][m][n] = __builtin_amdgcn_mfma_f32_16x16x32_bf16(Bt[n][k], At[m][k], acc[ai][bj][m][n], 0, 0, 0); __builtin_amdgcn_s_setprio(0); } while (0)
#define PG8_WAIT_V(n) asm volatile("s_waitcnt vmcnt(" #n ")" ::: "memory")
#define PG8_WAIT_L(n) asm volatile("s_waitcnt lgkmcnt(" #n ")" ::: "memory")
#define PG8_BAR __builtin_amdgcn_s_barrier()
#define PG8_SCHED __builtin_amdgcn_sched_barrier(0)
    Unit cur, nxt; int ui = 0;
    if (!S.next(0, cur)) return;
    f32x4 acc[2][2][4][2];
#pragma unroll
    for (int a = 0; a < 2; ++a)
#pragma unroll
        for (int b = 0; b < 2; ++b)
#pragma unroll
            for (int m = 0; m < 4; ++m)
#pragma unroll
                for (int n = 0; n < 2; ++n) acc[a][b][m][n] = (f32x4){0.f, 0.f, 0.f, 0.f};
    bf16x8 At[4][2], B0[2][2], B1[2][2];
    const char* cA = (const char*)g.A + (size_t)cur.pm * tstep; const char* cB = (const char*)g.Bt + (size_t)cur.pn * tstep;
    S.a_ready(cur);
    if constexpr (SP2) {
        PG8_STAGE(PG8_SB(0, 0), cB, voffB); PG8_STAGE(PG8_SB(0, 1), cB + hstep, voffB); PG8_STAGE(PG8_SA(0, 0), cA, voffA); PG8_STAGE(PG8_SA(0, 1), cA + hstep, voffA);
        if (wr == 1) PG8_BAR;
        PG8_WAIT_V(2); PG8_BAR;
        PG8_STAGE(PG8_SB(1, 0), cB + kstep, voffB); PG8_STAGE(PG8_SA(1, 0), cA + kstep, voffA); PG8_STAGE(PG8_SB(1, 1), cB + hstep + kstep, voffB);
        PG8_WAIT_V(6); PG8_BAR;
    } else {
        PG8_STAGE(PG8_SB(0, 0), cB, voffB); PG8_STAGE(PG8_SA(0, 0), cA, voffA); PG8_STAGE(PG8_SB(0, 1), cB + hstep, voffB); PG8_STAGE(PG8_SA(0, 1), cA + hstep, voffA);
        if (wr == 1) PG8_BAR;
        PG8_WAIT_V(4); PG8_BAR;
        PG8_STAGE(PG8_SB(1, 0), cB + kstep, voffB); PG8_STAGE(PG8_SA(1, 0), cA + kstep, voffA); PG8_STAGE(PG8_SB(1, 1), cB + hstep + kstep, voffB);
        PG8_WAIT_V(6); PG8_BAR;
    }
    for (;;) {
        const bool has_next = S.next(ui + 1, nxt);
        const char* nA = has_next ? (const char*)g.A + (size_t)nxt.pm * tstep : cA; const char* nB = has_next ? (const char*)g.Bt + (size_t)nxt.pn * tstep : cB;
        for (int t = 0; t < nt; t += 2) {
            const bool last = (t == nt - 2);
            const char* a1 = cA + (size_t)(t + 1) * kstep;
            const char* a2 = last ? nA : cA + (size_t)(t + 2) * kstep; const char* b2 = last ? nB : cB + (size_t)(t + 2) * kstep;
            const char* a3 = a2 + kstep; const char* b3 = b2 + kstep;
            if (last && has_next) S.a_ready(nxt);
            if constexpr (SP2) {
            PG8_LDB(B0, 0, 0); PG8_LDB(B1, 0, 1); PG8_SCHED; PG8_LDA(At, 0, 0); PG8_STAGE(PG8_SA(1, 1), a1 + hstep, voffA);
            PG8_WAIT_V(8); PG8_WAIT_L(0); PG8_BAR; PG8_MMA(0, 0, At, B0); PG8_MMA(0, 1, At, B1); PG8_BAR; PG8_SCHED;
            PG8_LDA(At, 0, 1); PG8_STAGE(PG8_SB(0, 0), b2, voffB); PG8_STAGE(PG8_SB(0, 1), b2 + hstep, voffB); PG8_STAGE(PG8_SA(0, 0), a2, voffA);
            PG8_WAIT_V(8); PG8_WAIT_L(0); PG8_BAR; PG8_MMA(1, 0, At, B0); PG8_MMA(1, 1, At, B1); PG8_BAR; PG8_SCHED;
            PG8_LDB(B0, 1, 0); PG8_LDB(B1, 1, 1); PG8_SCHED; PG8_LDA(At, 1, 0); PG8_STAGE(PG8_SA(0, 1), a2 + hstep, voffA);
            PG8_WAIT_V(8); PG8_WAIT_L(0); PG8_BAR; PG8_MMA(0, 0, At, B0); PG8_MMA(0, 1, At, B1); PG8_BAR; PG8_SCHED;
            PG8_LDA(At, 1, 1); PG8_STAGE(PG8_SB(1, 0), b3, voffB); PG8_STAGE(PG8_SB(1, 1), b3 + hstep, voffB); PG8_STAGE(PG8_SA(1, 0), a3, voffA);
            PG8_WAIT_V(8); PG8_WAIT_L(0); PG8_BAR; PG8_MMA(1, 0, At, B0); PG8_MMA(1, 1, At, B1); PG8_BAR; PG8_SCHED;
            } else {
            PG8_LDB(B0, 0, 0); PG8_SCHED; PG8_LDA(At, 0, 0); PG8_STAGE(PG8_SA(1, 1), a1 + hstep, voffA);
            PG8_WAIT_L(8); PG8_BAR; PG8_WAIT_L(0); PG8_MMA(0, 0, At, B0); PG8_BAR; PG8_SCHED;
            PG8_LDB(B1, 0, 1); PG8_STAGE(PG8_SB(0, 0), b2, voffB);
            PG8_BAR; PG8_WAIT_L(0); PG8_MMA(0, 1, At, B1); PG8_BAR;
            PG8_LDA(At, 0, 1); PG8_STAGE(PG8_SA(0, 0), a2, voffA);
            PG8_BAR; PG8_WAIT_L(0); PG8_MMA(1, 0, At, B0); PG8_BAR; PG8_SCHED;
            PG8_STAGE(PG8_SB(0, 1), b2 + hstep, voffB);
            PG8_WAIT_V(6); PG8_BAR; PG8_MMA(1, 1, At, B1); PG8_BAR;
            PG8_LDB(B0, 1, 0); PG8_SCHED; PG8_LDA(At, 1, 0); PG8_STAGE(PG8_SA(0, 1), a2 + hstep, voffA);
            PG8_WAIT_L(8); PG8_BAR; PG8_WAIT_L(0); PG8_MMA(0, 0, At, B0); PG8_BAR; PG8_SCHED;
            PG8_LDB(B1, 1, 1); PG8_STAGE(PG8_SB(1, 0), b3, voffB);
            PG8_BAR; PG8_WAIT_L(0); PG8_MMA(0, 1, At, B1); PG8_BAR;
            PG8_LDA(At, 1, 1); PG8_STAGE(PG8_SA(1, 0), a3, voffA);
            PG8_BAR; PG8_WAIT_L(0); PG8_MMA(1, 0, At, B0); PG8_BAR; PG8_SCHED;
            PG8_STAGE(PG8_SB(1, 1), b3 + hstep, voffB);
            PG8_WAIT_V(6); PG8_BAR; PG8_MMA(1, 1, At, B1); PG8_BAR;
            }
        }
        if constexpr (ALIGN_EPI) { if (wr == 0) PG8_BAR; }
        if constexpr (!Epi::AFTER_DRAIN) { E(acc, cur, wr, wc, fr, fq); S.done(cur); }
        if (!has_next) break;
#pragma unroll
        for (int a = 0; a < 2; ++a)
#pragma unroll
            for (int b = 0; b < 2; ++b)
#pragma unroll
                for (int m = 0; m < 4; ++m)
#pragma unroll
                    for (int n = 0; n < 2; ++n) acc[a][b][m][n] = (f32x4){0.f, 0.f, 0.f, 0.f};
        cur = nxt; cA = nA; cB = nB; ++ui;
        if constexpr (ALIGN_EPI) { if (wr == 1) PG8_BAR; }
    }
    PG8_WAIT_V(0);
    if constexpr (!ALIGN_EPI) { if (wr == 0) PG8_BAR; }
    PG8_BAR;
    if constexpr (Epi::AFTER_DRAIN) { E.fused(acc, cur, wr, wc, fr, fq, lds, wid, lane); S.done(cur); }
#undef PG8_SA
#undef PG8_SB
#undef PG8_STAGE
#undef PG8_LDA
#undef PG8_LDB
#undef PG8_MMA
#undef PG8_WAIT_V
#undef PG8_WAIT_L
#undef PG8_BAR
#undef PG8_SCHED
}
}

constexpr int NWAVES = 8;
#ifndef MK_N_LAUNCHES
#define MK_N_LAUNCHES 1
#endif
constexpr int NPHASE = 9;
constexpr int N_LAUNCHES = MK_N_LAUNCHES;
static_assert(N_LAUNCHES == 1 || N_LAUNCHES == NPHASE, "MK_N_LAUNCHES is 1 or 9");

constexpr int T = 8192, D = 2048, NIN = 6144, AW = 1024, CW = 1024, NH = 8, HD = 128, GW = 64, GR = 128;
constexpr int NE = 32, TOPK = 4, FF = 2048;
constexpr float EPS = 1e-5f;
constexpr int NSLOT = T * TOPK + NE * 256;

constexpr size_t MiB = 1u << 20;
constexpr size_t WS_CTL = 0, CTL_ZERO_BYTES = 1 * MiB;
constexpr size_t WS_RWT   = 1 * MiB;
constexpr size_t WS_BIASM = 2 * MiB;
constexpr size_t WS_TOK   = 3 * MiB;
constexpr size_t WS_WIN   = 4 * MiB;
constexpr size_t WS_WOUT  = 28 * MiB;
constexpr size_t WS_XN    = 36 * MiB;
constexpr size_t WS_PROJ  = 68 * MiB;
constexpr size_t WS_MIXED = 164 * MiB;
constexpr size_t WS_H     = 196 * MiB;
constexpr size_t WS_HN    = 260 * MiB;
constexpr size_t WS_XG    = 292 * MiB;
constexpr size_t WS_ACT   = 452 * MiB;
constexpr size_t WS_Y     = 612 * MiB;
constexpr size_t WS_WGU   = 772 * MiB;
constexpr size_t WS_WDN   = 1284 * MiB;
constexpr size_t WS_END   = 1540 * MiB;
static_assert((size_t)NSLOT * D * 2 <= 160 * MiB, "slot matrices");
constexpr int CW_TMO = 0, CW_CODE = 1;
constexpr int CW_CNT = 64;
constexpr int CW_BAR = 4096;

constexpr int RING_OFF = 0, RING_BYTES = 131072;
constexpr int LDSCTL_OFF = RING_BYTES, MISC_OFF = LDSCTL_OFF + 320;
constexpr int LDS_BYTES = 147456;
static_assert(MISC_OFF + 4 * 64 <= LDS_BYTES, "LDS map");

#define GAS __attribute__((address_space(1)))
#define LAS __attribute__((address_space(3)))
typedef unsigned short bf16;
typedef unsigned v4u __attribute__((ext_vector_type(4)));
typedef unsigned v2u __attribute__((ext_vector_type(2)));
typedef float f32x4 __attribute__((ext_vector_type(4)));
typedef float f32x16 __attribute__((ext_vector_type(16)));
typedef short bf16x8 __attribute__((ext_vector_type(8)));
typedef short s16x4 __attribute__((ext_vector_type(4)));
typedef GAS unsigned gu32;
#define RLX_AGENT __ATOMIC_RELAXED, __HIP_MEMORY_SCOPE_AGENT
#define LDS_WAIT() asm volatile("s_waitcnt lgkmcnt(0)" ::: "memory")
#define VM_WAIT() asm volatile("s_waitcnt vmcnt(0)" ::: "memory")
__device__ __forceinline__ unsigned pk2(float lo, float hi) { unsigned r; asm volatile("v_cvt_pk_bf16_f32 %0, %1, %2" : "=v"(r) : "v"(lo), "v"(hi)); return r; }
__device__ __forceinline__ float bf_lo(unsigned w) { return __uint_as_float(w << 16); }
__device__ __forceinline__ float bf_hi(unsigned w) { return __uint_as_float(w & 0xffff0000u); }
#define XB_TMO      128
#define XB_XCNT(j)  (256  + 64 * (j))
#define XB_XSUB(j)  (1280 + 64 * (j))
#define XB_XGEN(j)  (2304 + 64 * (j))
#define XB_TOP      3328
#define XB_TOPGEN   3392
#define XCD_BAR_WORDS 3456
#define XB_SPIN_CAP (1u << 18)

__device__ __forceinline__ unsigned xb_ld(unsigned* p)              { return __hip_atomic_load(p, __ATOMIC_RELAXED, __HIP_MEMORY_SCOPE_AGENT); }
__device__ __forceinline__ unsigned xb_add(unsigned* p, unsigned v) { return __hip_atomic_fetch_add(p, v, __ATOMIC_RELAXED, __HIP_MEMORY_SCOPE_AGENT); }
__device__ __forceinline__ unsigned xb_xcc_id() { return (unsigned)__builtin_amdgcn_s_getreg((3 << 11) | 20) & 0xFu; }
#define XB_SPIN(cond, bar) do { unsigned _sp = 0; while (cond) { __builtin_amdgcn_s_sleep(1); \
    if ((++_sp & 255u) == 0u) { if (xb_ld(&(bar)[XB_TMO])) break; if (_sp > XB_SPIN_CAP) { atomicAdd(&(bar)[XB_TMO], 1u); break; } } } } while (0)

struct XcdBarrier {
    unsigned* bar; unsigned x;
    volatile LAS unsigned* st;
};

__device__ __forceinline__ XcdBarrier xcd_barrier_post(unsigned* bar, volatile LAS unsigned* st) {
    XcdBarrier b; b.bar = bar; b.x = xb_xcc_id(); b.st = st;
    if (threadIdx.x == 0) (void)xb_add(&bar[XB_XCNT(b.x)], 1u);
    return b;
}
__device__ __forceinline__ void xcd_barrier_complete(unsigned* bar, unsigned x, unsigned& nloc, unsigned& nx) {
    const unsigned G = gridDim.x * gridDim.y * gridDim.z;
    unsigned sum, cnt, mine, sp = 0u;
    for (;;) {
        sum = 0u; cnt = 0u; mine = 0u;
#pragma unroll
        for (unsigned j = 0; j < 16; ++j) { const unsigned c = xb_ld(&bar[XB_XCNT(j)]); sum += c; cnt += (c > 0u) ? 1u : 0u; mine = (j == x) ? c : mine; }
        if (sum == G) break;
        __builtin_amdgcn_s_sleep(1);
        if ((++sp & 255u) == 0u) { if (xb_ld(&bar[XB_TMO])) break; if (sp > XB_SPIN_CAP) { atomicAdd(&bar[XB_TMO], 1u); break; } }
    }
    nloc = mine > 0u ? mine : 1u; nx = cnt > 0u ? cnt : 1u;
}

__device__ __forceinline__ void xcd_barrier(const XcdBarrier& b) {
    asm volatile("s_waitcnt vmcnt(0)" ::: "memory");
    __syncthreads();
    if (threadIdx.x == 0) {
        unsigned* bar = b.bar;
        __builtin_amdgcn_s_waitcnt(0);
        unsigned nloc = b.st[0], nx = b.st[1];
        if (nloc == 0u) { xcd_barrier_complete(bar, b.x, nloc, nx); b.st[0] = nloc; b.st[1] = nx; }
        const unsigned old = xb_add(&bar[XB_XSUB(b.x)], 1u);
        const unsigned gen = old / nloc;
        if (old + 1u == (gen + 1u) * nloc) {
            __builtin_amdgcn_fence(__ATOMIC_RELEASE, "agent");
            asm volatile("s_waitcnt vmcnt(0)" ::: "memory");
            const unsigned og = xb_add(&bar[XB_TOP], 1u);
            const unsigned tg = og / nx;
            if (og + 1u == (tg + 1u) * nx) xb_add(&bar[XB_TOPGEN], 1u);
            else XB_SPIN(xb_ld(&bar[XB_TOPGEN]) == tg, bar);
            __builtin_amdgcn_fence(__ATOMIC_ACQUIRE, "agent");
            xb_add(&bar[XB_XGEN(b.x)], 1u);
            asm volatile("s_waitcnt vmcnt(0)" ::: "memory");
        } else {
            XB_SPIN(xb_ld(&bar[XB_XGEN(b.x)]) == gen, bar);
            __builtin_amdgcn_fence(__ATOMIC_ACQUIRE, "agent");
            asm volatile("s_waitcnt vmcnt(0)" ::: "memory");
        }
    }
    __syncthreads();
}

struct Frame {
    LAS unsigned char* lds;
    volatile LAS unsigned* MISC;
    gu32* ctl;
    int tid, lane, wave;
    int vcu, G;
    const float *x, *attn_norm_w, *w_in, *conv_w, *rpb, *aon_w, *con_w, *w_out, *ffn_norm_w, *router_w, *router_b, *w_gu, *b_gu, *w_dn, *b_dn, *final_w;
    float* out;
    unsigned char* ws;
};
__device__ __forceinline__ float wave_sum(float v) {
#pragma unroll
    for (int o = 1; o < 64; o <<= 1) v += __shfl_xor(v, o);
    return v;
}
__device__ __forceinline__ float wave_max(float v) {
#pragma unroll
    for (int o = 1; o < 64; o <<= 1) v = fmaxf(v, __shfl_xor(v, o));
    return v;
}

template <bool GU>
__device__ __forceinline__ void p0_transpose_item(const float* W, int K, int N, bf16* WT, LAS float* scr, int item, int lane) {
    const int nblk = N / 32, kb = item / nblk, nb = item % nblk, k0 = 64 * kb, n0 = 32 * nb;
#pragma unroll 8
    for (int i = 0; i < 32; ++i) { const int kk = 2 * i + (lane >> 5); scr[kk * 33 + (lane & 31)] = W[(size_t)(k0 + kk) * N + n0 + (lane & 31)]; }
    LDS_WAIT(); asm volatile("" ::: "memory");
    const int c = lane & 7;
    const int nd0 = GU ? (((n0 & 2047) >> 7) * 256 + (n0 >> 11) * 128 + (n0 & 127)) : n0;
#pragma unroll
    for (int j = 0; j < 4; ++j) { const int n = (lane >> 3) + 8 * j; const LAS float* s = scr + (8 * c) * 33 + n;
        v4u o; o.x = pk2(s[0 * 33], s[1 * 33]); o.y = pk2(s[2 * 33], s[3 * 33]); o.z = pk2(s[4 * 33], s[5 * 33]); o.w = pk2(s[6 * 33], s[7 * 33]);
        *(GAS v4u*)(WT + (size_t)(nd0 + n) * K + k0 + 8 * c) = o; }
    LDS_WAIT(); asm volatile("" ::: "memory");
}
__device__ __forceinline__ void rms_row_to_bf16(int lane, const float* xrow, const float* w, bf16* orow) {
    const GAS f32x4* xr = (const GAS f32x4*)xrow + lane; const GAS f32x4* wr = (const GAS f32x4*)w + lane;
    f32x4 v[8]; float s = 0.f;
#pragma unroll
    for (int j = 0; j < 8; ++j) { v[j] = xr[64 * j]; s += (v[j].x * v[j].x + v[j].y * v[j].y) + (v[j].z * v[j].z + v[j].w * v[j].w); }
    const float rstd = 1.0f / sqrtf(wave_sum(s) * (1.f / D) + EPS);
    GAS v2u* o8 = (GAS v2u*)orow + lane;
#pragma unroll
    for (int j = 0; j < 8; ++j) { const f32x4 g = wr[64 * j]; v2u o; o.x = pk2(v[j].x * rstd * g.x, v[j].y * rstd * g.y); o.y = pk2(v[j].z * rstd * g.z, v[j].w * rstd * g.w); o8[64 * j] = o; }
}
__device__ __forceinline__ void p0_prologue(Frame& F) {
    LAS float* scr = (LAS float*)(F.lds + RING_OFF + F.wave * 16384);
    const int gw = F.vcu * NWAVES + F.wave, NGW = F.G * NWAVES;
    constexpr int I_IN = (D / 64) * (NIN / 32), I_OUT = (D / 64) * (D / 32), I_GU = (D / 64) * (2 * FF / 32), I_DN = (FF / 64) * (D / 32);
    constexpr int NITEMS = I_IN + I_OUT + NE * I_GU + NE * I_DN;
    bf16* WIN = (bf16*)(F.ws + WS_WIN); bf16* WOUT = (bf16*)(F.ws + WS_WOUT); bf16* WGU = (bf16*)(F.ws + WS_WGU); bf16* WDN = (bf16*)(F.ws + WS_WDN);
    for (int m = gw; m < T; m += NGW) rms_row_to_bf16(F.lane, F.x + (size_t)m * D, F.attn_norm_w, (bf16*)(F.ws + WS_XN) + (size_t)m * D);
    {
        float* RWT = (float*)(F.ws + WS_RWT);
        for (int i = (int)blockIdx.x * 512 + F.tid; i < NE * D; i += F.G * 512) { const int e = i / D, k = i % D; RWT[i] = F.ffn_norm_w[k] * F.router_w[(size_t)k * NE + e]; }
        bf16* BM_ = (bf16*)(F.ws + WS_BIASM);
        for (int i = (int)blockIdx.x * 512 + F.tid; i < NH * 15 * 64 * 64; i += F.G * 512) {
            const int c = i & 63, kc = (i >> 6) & 63, hd = i >> 12;
            int cs = c - 8; cs = cs < 0 ? 0 : (cs > 48 ? 48 : cs);
            const bool in = (kc >= cs) && (kc < cs + 16);
            const float v = in ? F.rpb[(size_t)hd * 31 + (kc - c + 15)] * 11.313708498984761f : -1e30f;
            BM_[i] = (bf16)(pk2(v, v) & 0xffffu);
        }
    }
    for (int it = gw; it < NITEMS; it += NGW) {
        int r = it;
        if (r < I_IN) { p0_transpose_item<false>(F.w_in, D, NIN, WIN, scr, r, F.lane); continue; } r -= I_IN;
        if (r < I_OUT) { p0_transpose_item<false>(F.w_out, D, D, WOUT, scr, r, F.lane); continue; } r -= I_OUT;
        if (r < NE * I_GU) { const int e = r / I_GU; p0_transpose_item<true>(F.w_gu + (size_t)e * D * 2 * FF, D, 2 * FF, WGU + (size_t)e * 2 * FF * D, scr, r % I_GU, F.lane); continue; } r -= NE * I_GU;
        { const int e = r / I_DN; p0_transpose_item<false>(F.w_dn + (size_t)e * FF * D, FF, D, WDN + (size_t)e * D * FF, scr, r % I_DN, F.lane); }
    }
}

namespace na {
constexpr int LDP = NIN;
constexpr float SCALE = 0.088388347648318440f, CL2 = SCALE * 1.4426950408889634f, THR = 8.f;
constexpr int SHM_V = 64 * 128 * 2, SHM_K = 64 * 128 * 2;
constexpr int OFF_V = 0, OFF_K = 2 * SHM_V, OFF_WS = 2 * SHM_V + 2 * SHM_K;
#define KSWZ(row, colB) ((row) * 256 + ((colB) ^ (((row) & 7) << 4)))
#define SBAR() __builtin_amdgcn_sched_barrier(0)
__device__ __forceinline__ int crow(int r, int hi) { return (r & 3) + 8 * (r >> 2) + 4 * hi; }
__device__ __forceinline__ int v_st(int k, int c) { const int kk = (k & ~0xC) | ((k & 4) << 1) | ((k & 8) >> 1); return ((kk >> 3) * 4 + (c >> 5)) * 512 + ((kk & 7) * 32 + (c & 31)) * 2; }
__device__ __forceinline__ int v_rd_base(int lane) { return ((lane & 3) << 3) | (((lane >> 2) & 3) << 6) | (((lane >> 4) & 1) << 5) | (((lane >> 5) & 1) << 8); }
constexpr int v_rd_off(int d0, int ks, int half) { return d0 * 512 + ks * 4096 + half * 2048; }
template <int OFF> __device__ __forceinline__ s16x4 tr_read(int vb) {
    s16x4 r; asm volatile("ds_read_b64_tr_b16 %0, %1 offset:%2" : "=&v"(r) : "v"(vb), "i"(OFF) : "memory"); return r;
}
template <int D0> __device__ __forceinline__ void pv_one(f32x16& od, int vb, bf16x8 pa0, bf16x8 pa1, bf16x8 pa2, bf16x8 pa3) {
    const s16x4 l0 = tr_read<v_rd_off(D0, 0, 0)>(vb), h0 = tr_read<v_rd_off(D0, 0, 1)>(vb), l1 = tr_read<v_rd_off(D0, 1, 0)>(vb), h1 = tr_read<v_rd_off(D0, 1, 1)>(vb);
    const s16x4 l2 = tr_read<v_rd_off(D0, 2, 0)>(vb), h2 = tr_read<v_rd_off(D0, 2, 1)>(vb), l3 = tr_read<v_rd_off(D0, 3, 0)>(vb), h3 = tr_read<v_rd_off(D0, 3, 1)>(vb);
    asm volatile("s_waitcnt lgkmcnt(0)" ::: "memory"); SBAR();
#define PK(L, H) (bf16x8){L[0], L[1], L[2], L[3], H[0], H[1], H[2], H[3]}
    od = __builtin_amdgcn_mfma_f32_32x32x16_bf16(pa0, PK(l0, h0), od, 0, 0, 0);
    od = __builtin_amdgcn_mfma_f32_32x32x16_bf16(pa1, PK(l1, h1), od, 0, 0, 0);
    od = __builtin_amdgcn_mfma_f32_32x32x16_bf16(pa2, PK(l2, h2), od, 0, 0, 0);
    od = __builtin_amdgcn_mfma_f32_32x32x16_bf16(pa3, PK(l3, h3), od, 0, 0, 0);
#undef PK
}
__device__ __forceinline__ void attn_unit(int h, int rb, const bf16* __restrict__ proj, const bf16* __restrict__ biasm, const float* __restrict__ nw, bf16* __restrict__ mixed, LAS unsigned char* lds) {
    const int tid = threadIdx.x, wid = __builtin_amdgcn_readfirstlane(tid >> 6), lane = tid & 63, r32 = lane & 31, hi = lane >> 5;
    const int r0 = rb * 4, gr = r0 + (wid >> 1), c0 = (wid & 1) * 32;
    int rs = gr - 4; rs = rs < 0 ? 0 : (rs > GR - 8 ? GR - 8 : rs);
    int ks = r0 - 4; ks = ks < 0 ? 0 : (ks > GR - 8 ? GR - 8 : ks);
    int ke = r0 + 3 - 4; ke = (ke < 0 ? 0 : (ke > GR - 8 ? GR - 8 : ke)) + 8;
    const int NT = ke - ks;
    LAS unsigned char* V_lds = lds + OFF_V; LAS unsigned char* K_lds = lds + OFF_K;
    LAS float* ws = (LAS float*)(lds + OFF_WS) + wid * 64; LAS float* li_l = ws; LAS float* al_l = ws + 32;
    float m_reg = -1e30f, l_reg = 0.f; f32x16 o[4] = {}; bf16x8 qr[8];
    const bf16* Qw = proj + (size_t)(gr * GW + c0 + r32) * LDP + h * HD + hi * 8;
#pragma unroll
    for (int d0 = 0; d0 < 8; ++d0) qr[d0] = *(const bf16x8*)(Qw + d0 * 16);
    bf16x8 qe[2];
#pragma unroll
    for (int s = 0; s < 2; ++s)
#pragma unroll
        for (int j = 0; j < 8; ++j) qe[s][j] = (16 * s + 8 * hi + j == r32) ? (short)0x3F80 : (short)0;
    const int sr = tid >> 4, sc = (tid & 15) * 8, vst0 = v_st(sr, sc), vst1 = v_st(32 + sr, sc);
    const int vb0 = (int)(uintptr_t)V_lds + v_rd_base(lane);
    const bf16* Kh = proj + AW + h * HD; const bf16* Vh = proj + 2 * AW + h * HD;
    bf16x8 vs0, vs1, ks0, ks1;
#define SLOAD(tok0) do { vs0 = *(const bf16x8*)(Vh + (size_t)((tok0) + sr) * LDP + sc); vs1 = *(const bf16x8*)(Vh + (size_t)((tok0) + 32 + sr) * LDP + sc); \
        ks0 = *(const bf16x8*)(Kh + (size_t)((tok0) + sr) * LDP + sc); ks1 = *(const bf16x8*)(Kh + (size_t)((tok0) + 32 + sr) * LDP + sc); } while (0)
#define SWRITE(b) do { *(LAS bf16x8*)(V_lds + (b) * SHM_V + vst0) = vs0; *(LAS bf16x8*)(V_lds + (b) * SHM_V + vst1) = vs1; const int kc_ = sc * 2; \
        *(LAS bf16x8*)(K_lds + (b) * SHM_K + KSWZ(sr, kc_)) = ks0; *(LAS bf16x8*)(K_lds + (b) * SHM_K + KSWZ(32 + sr, kc_)) = ks1; } while (0)
    SLOAD(ks * GW); SWRITE(0); __syncthreads();
    for (int j = 0; j < NT; ++j) {
        const int kr = ks + j, b = j & 1;
        const bool active = (kr >= rs) && (kr < rs + 8);
        bf16x8 ae00, ae01, ae10, ae11;
        if (active) { const bf16* bp = biasm + ((size_t)((h * 15 + (kr - gr + 7)) * 64 + r32) * 64 + c0 + 8 * hi);
            ae00 = *(const bf16x8*)(bp); ae01 = *(const bf16x8*)(bp + 16); ae10 = *(const bf16x8*)(bp + 32 * 64); ae11 = *(const bf16x8*)(bp + 32 * 64 + 16); }
        if (j + 1 < NT) SLOAD((kr + 1) * GW);
        if (active) {
            f32x16 p0 = {}, p1 = {};
            const LAS unsigned char* Kb = K_lds + b * SHM_K;
#pragma unroll
            for (int d0 = 0; d0 < 8; ++d0) { const int cb = (d0 * 16 + hi * 8) * 2;
                const bf16x8 b0 = *(const LAS bf16x8*)(Kb + KSWZ(r32, cb)), b1 = *(const LAS bf16x8*)(Kb + KSWZ(32 + r32, cb));
                p0 = __builtin_amdgcn_mfma_f32_32x32x16_bf16(b0, qr[d0], p0, 0, 0, 0);
                p1 = __builtin_amdgcn_mfma_f32_32x32x16_bf16(b1, qr[d0], p1, 0, 0, 0); }
            p0 = __builtin_amdgcn_mfma_f32_32x32x16_bf16(ae00, qe[0], p0, 0, 0, 0); p0 = __builtin_amdgcn_mfma_f32_32x32x16_bf16(ae01, qe[1], p0, 0, 0, 0);
            p1 = __builtin_amdgcn_mfma_f32_32x32x16_bf16(ae10, qe[0], p1, 0, 0, 0); p1 = __builtin_amdgcn_mfma_f32_32x32x16_bf16(ae11, qe[1], p1, 0, 0, 0);
            float pmax = p0[0];
#pragma unroll
            for (int r = 1; r < 16; ++r) pmax = fmaxf(pmax, p0[r]);
#pragma unroll
            for (int r = 0; r < 16; ++r) pmax = fmaxf(pmax, p1[r]);
            { auto rr = __builtin_amdgcn_permlane32_swap(__float_as_uint(pmax), __float_as_uint(pmax), false, false); pmax = fmaxf(__uint_as_float(rr[0]), __uint_as_float(rr[1])); }
            float mn, alpha;
            if (__all(pmax - m_reg <= THR / SCALE)) { mn = m_reg; alpha = 1.f; }
            else { mn = fmaxf(m_reg, pmax); alpha = __builtin_amdgcn_exp2f((m_reg - mn) * CL2); m_reg = mn; }
            const float mnC = -mn * CL2;
#pragma unroll
            for (int r = 0; r < 16; ++r) { p0[r] = __builtin_amdgcn_exp2f(fmaf(p0[r], CL2, mnC)); p1[r] = __builtin_amdgcn_exp2f(fmaf(p1[r], CL2, mnC)); }
            float ps = 0.f;
#pragma unroll
            for (int r = 0; r < 16; ++r) ps += p0[r] + p1[r];
            { auto rr = __builtin_amdgcn_permlane32_swap(__float_as_uint(ps), __float_as_uint(ps), false, false); ps = __uint_as_float(rr[0]) + __uint_as_float(rr[1]); }
            l_reg = l_reg * alpha + ps;
            if (__any(alpha < 1.f)) { if (hi == 0) al_l[r32] = alpha; LDS_WAIT();
#pragma unroll
                for (int d = 0; d < 4; ++d)
#pragma unroll
                    for (int r = 0; r < 16; ++r) o[d][r] *= al_l[crow(r, hi)];
            }
            bf16x8 pa0, pa1, pa2, pa3;
#define PK4(P, BASE, OUT) do { unsigned a0 = pk2(P[BASE + 0], P[BASE + 1]), a1 = pk2(P[BASE + 2], P[BASE + 3]); \
    unsigned b0_ = pk2(P[BASE + 4], P[BASE + 5]), b1_ = pk2(P[BASE + 6], P[BASE + 7]); \
    auto r0_ = __builtin_amdgcn_permlane32_swap(a0, b0_, false, false); auto r1_ = __builtin_amdgcn_permlane32_swap(a1, b1_, false, false); \
    v4u w_ = {r0_[0], r1_[0], r0_[1], r1_[1]}; OUT = __builtin_bit_cast(bf16x8, w_); } while (0)
            PK4(p0, 0, pa0); PK4(p0, 8, pa1); PK4(p1, 0, pa2); PK4(p1, 8, pa3);
#undef PK4
            const int vb = vb0 + b * SHM_V;
            pv_one<0>(o[0], vb, pa0, pa1, pa2, pa3); pv_one<1>(o[1], vb, pa0, pa1, pa2, pa3); pv_one<2>(o[2], vb, pa0, pa1, pa2, pa3); pv_one<3>(o[3], vb, pa0, pa1, pa2, pa3);
        }
        if (j + 1 < NT) SWRITE(b ^ 1);
        __syncthreads();
    }
#undef SLOAD
#undef SWRITE
    if (hi == 0) li_l[r32] = l_reg; LDS_WAIT();
    float rli[16], ss[16];
#pragma unroll
    for (int r = 0; r < 16; ++r) { rli[r] = __builtin_amdgcn_rcpf(li_l[crow(r, hi)]); float a = 0.f;
#pragma unroll
        for (int d = 0; d < 4; ++d) { o[d][r] *= rli[r]; a += o[d][r] * o[d][r]; }
        ss[r] = a; }
#pragma unroll
    for (int r = 0; r < 16; ++r) {
#pragma unroll
        for (int s = 1; s < 32; s <<= 1) ss[r] += __shfl_xor(ss[r], s);
        ss[r] = 1.0f / sqrtf(ss[r] * (1.f / HD) + EPS); }
    float nwv[4];
#pragma unroll
    for (int d = 0; d < 4; ++d) nwv[d] = nw[h * HD + d * 32 + r32];
    bf16* Ow = mixed + (size_t)(gr * GW + c0) * D + h * HD + r32;
#pragma unroll
    for (int r = 0; r < 16; ++r) { const int orow = crow(r, hi);
#pragma unroll
        for (int d = 0; d < 4; ++d) { const float v = o[d][r] * ss[r] * nwv[d]; Ow[(size_t)orow * D + d * 32] = (bf16)(pk2(v, v) & 0xffffu); } }
    __syncthreads();
}
#undef KSWZ
#undef SBAR
__device__ __forceinline__ void conv_item(int item, int lane, const bf16* __restrict__ proj, const float* __restrict__ cw, const float* __restrict__ nw, bf16* __restrict__ mixed) {
    const int t0 = item * 4;
#pragma unroll 1
    for (int cc = 0; cc < 2; ++cc) {
        const int ch = cc * 512 + 8 * lane;
        float w0[8], w1[8], w2[8], g[8];
#pragma unroll
        for (int i = 0; i < 8; ++i) { w0[i] = cw[ch + i]; w1[i] = cw[CW + ch + i]; w2[i] = cw[2 * CW + ch + i]; g[i] = nw[ch + i]; }
        float z[6][8];
#pragma unroll
        for (int tt = 0; tt < 6; ++tt) { const int t = t0 + tt - 1;
            if (t >= 0 && t < T) { const v4u uu = *(const v4u*)(proj + (size_t)t * LDP + 3 * AW + ch), cv = *(const v4u*)(proj + (size_t)t * LDP + 3 * AW + 2 * CW + ch);
#pragma unroll
                for (int q = 0; q < 4; ++q) { z[tt][2 * q] = bf_lo(uu[q]) * bf_lo(cv[q]); z[tt][2 * q + 1] = bf_hi(uu[q]) * bf_hi(cv[q]); } }
            else {
#pragma unroll
                for (int i = 0; i < 8; ++i) z[tt][i] = 0.f; } }
#pragma unroll
        for (int tt = 0; tt < 4; ++tt) { const int t = t0 + tt;
            const v4u bb = *(const v4u*)(proj + (size_t)t * LDP + 3 * AW + CW + ch);
            float y[8], s = 0.f;
#pragma unroll
            for (int q = 0; q < 4; ++q) { const float b0 = bf_lo(bb[q]), b1 = bf_hi(bb[q]); const int i0 = 2 * q, i1 = 2 * q + 1;
                y[i0] = b0 * (w0[i0] * z[tt][i0] + w1[i0] * z[tt + 1][i0] + w2[i0] * z[tt + 2][i0]);
                y[i1] = b1 * (w0[i1] * z[tt][i1] + w1[i1] * z[tt + 1][i1] + w2[i1] * z[tt + 2][i1]);
                s += y[i0] * y[i0] + y[i1] * y[i1]; }
#pragma unroll
            for (int o = 1; o < 16; o <<= 1) s += __shfl_xor(s, o);
            const float rstd = 1.0f / sqrtf(s * (1.f / 128.f) + EPS);
            v4u ov; ov.x = pk2(y[0] * rstd * g[0], y[1] * rstd * g[1]); ov.y = pk2(y[2] * rstd * g[2], y[3] * rstd * g[3]); ov.z = pk2(y[4] * rstd * g[4], y[5] * rstd * g[5]); ov.w = pk2(y[6] * rstd * g[6], y[7] * rstd * g[7]);
            *(v4u*)(mixed + (size_t)t * D + AW + ch) = ov; }
    }
}
}

__device__ __forceinline__ void route_tile(Frame& F, int tb) {
    const int lane = F.lane, w = F.wave;
    const float* H = (const float*)(F.ws + WS_H); bf16* HN = (bf16*)(F.ws + WS_HN); const float* RWT = (const float*)(F.ws + WS_RWT);
    LAS f32x4* tab = (LAS f32x4*)(F.lds + RING_OFF);
    f32x4 v[4][8]; float lg[4];
#pragma unroll
    for (int i = 0; i < 4; ++i) { const int t = tb * 32 + w * 4 + i; const GAS f32x4* xr = (const GAS f32x4*)(H + (size_t)t * D) + lane; float s = 0.f;
#pragma unroll
        for (int j = 0; j < 8; ++j) { v[i][j] = xr[64 * j]; s += (v[i][j].x * v[i][j].x + v[i][j].y * v[i][j].y) + (v[i][j].z * v[i][j].z + v[i][j].w * v[i][j].w); }
        const float rstd = 1.0f / sqrtf(wave_sum(s) * (1.f / D) + EPS);
        GAS v2u* o8 = (GAS v2u*)(HN + (size_t)t * D) + lane; const GAS f32x4* fw = (const GAS f32x4*)F.ffn_norm_w + lane;
#pragma unroll
        for (int j = 0; j < 8; ++j) { v[i][j] = v[i][j] * rstd; const f32x4 g = fw[64 * j]; v2u o; o.x = pk2(v[i][j].x * g.x, v[i][j].y * g.y); o.y = pk2(v[i][j].z * g.z, v[i][j].w * g.w); o8[64 * j] = o; }
        lg[i] = 0.f; }
#pragma unroll 1
    for (int chunk = 0; chunk < 2; ++chunk) {
        __syncthreads();
        { const GAS f32x4* src = (const GAS f32x4*)(RWT + (size_t)chunk * 16 * D);
#pragma unroll
          for (int q = 0; q < 16; ++q) tab[q * 512 + F.tid] = src[q * 512 + F.tid]; }
        __syncthreads();
#pragma unroll 1
        for (int el = 0; el < 16; ++el) {
            float a[4] = {0.f, 0.f, 0.f, 0.f};
#pragma unroll
            for (int j = 0; j < 8; ++j) { const f32x4 wv = tab[el * 512 + 64 * j + lane];
#pragma unroll
                for (int i = 0; i < 4; ++i) a[i] += (v[i][j].x * wv.x + v[i][j].y * wv.y) + (v[i][j].z * wv.z + v[i][j].w * wv.w); }
#pragma unroll
            for (int i = 0; i < 4; ++i) { const float s = wave_sum(a[i]); lg[i] = (lane == chunk * 16 + el) ? s : lg[i]; }
        }
    }
    const float rb = lane < NE ? F.router_b[lane] : 0.f;
#pragma unroll
    for (int i = 0; i < 4; ++i) { const int t = tb * 32 + w * 4 + i;
        float val = lane < NE ? lg[i] + rb : -3.0e38f;
        float tv[4]; int te[4];
#pragma unroll
        for (int k = 0; k < 4; ++k) { const float m = wave_max(val); const unsigned long long bal = __ballot(val == m); const int idx = __builtin_ctzll(bal); tv[k] = m; te[k] = idx; if (lane == idx) val = -3.0e38f; }
        float ex[4], den = 0.f;
#pragma unroll
        for (int k = 0; k < 4; ++k) { ex[k] = __expf(tv[k] - tv[0]); den += ex[k]; }
        const float inv = 1.0f / den;
        if (lane < 4) { const int e = lane == 0 ? te[0] : lane == 1 ? te[1] : lane == 2 ? te[2] : te[3]; const float gt = (lane == 0 ? ex[0] : lane == 1 ? ex[1] : lane == 2 ? ex[2] : ex[3]) * inv;
            const unsigned pos = __hip_atomic_fetch_add((unsigned*)(F.ctl + CW_CNT) + e, 1u, RLX_AGENT);
            v4u rec; rec.x = (unsigned)e; rec.y = pos; rec.z = __float_as_uint(gt); rec.w = 0u;
            *(GAS v4u*)((v4u*)(F.ws + WS_TOK) + (size_t)t * 4 + lane) = rec; }
    }
}
__device__ __forceinline__ int expert_tile_prefix(Frame& F, int& total) {
    const int lane = F.lane;
    const int c = lane < NE ? (int)__hip_atomic_load((unsigned*)(F.ctl + CW_CNT) + lane, RLX_AGENT) : 0;
    const int mt = (c + 255) >> 8;
    int incl = mt;
#pragma unroll
    for (int o = 1; o < 32; o <<= 1) { const int y = __shfl_up(incl, o); if ((lane & 31) >= o) incl += y; }
    total = __shfl(incl, 31);
    return incl - mt;
}
__device__ __forceinline__ void p5_dispatch(Frame& F) {
    int total; const int tbl = expert_tile_prefix(F, total);
    const int gw = F.vcu * NWAVES + F.wave, NGW = F.G * NWAVES, lane = F.lane;
    const bf16* HN = (const bf16*)(F.ws + WS_HN); bf16* XG = (bf16*)(F.ws + WS_XG);
    for (int t = gw; t < T; t += NGW) {
        GAS v4u* recp = (GAS v4u*)((v4u*)(F.ws + WS_TOK) + (size_t)t * 4);
        const v4u r0 = recp[0], r1 = recp[1], r2 = recp[2], r3 = recp[3];
        const int s0 = __shfl(tbl, (int)r0.x) * 256 + (int)r0.y, s1 = __shfl(tbl, (int)r1.x) * 256 + (int)r1.y, s2 = __shfl(tbl, (int)r2.x) * 256 + (int)r2.y, s3 = __shfl(tbl, (int)r3.x) * 256 + (int)r3.y;
        if (lane < 4) { const int s = lane == 0 ? s0 : lane == 1 ? s1 : lane == 2 ? s2 : s3; ((GAS unsigned*)(recp + lane))[3] = (unsigned)s; }
        const GAS v4u* src = (const GAS v4u*)(HN + (size_t)t * D) + lane;
        v4u a[4];
#pragma unroll
        for (int j = 0; j < 4; ++j) a[j] = src[64 * j];
#pragma unroll
        for (int j = 0; j < 4; ++j) { ((GAS v4u*)(XG + (size_t)s0 * D) + lane)[64 * j] = a[j]; ((GAS v4u*)(XG + (size_t)s1 * D) + lane)[64 * j] = a[j];
            ((GAS v4u*)(XG + (size_t)s2 * D) + lane)[64 * j] = a[j]; ((GAS v4u*)(XG + (size_t)s3 * D) + lane)[64 * j] = a[j]; }
    }
}
__device__ __forceinline__ void moe_table_to_lds(Frame& F) {
    if (F.wave == 0) { int total; const int tbl = expert_tile_prefix(F, total); if (F.lane < NE) F.MISC[16 + F.lane] = (unsigned)tbl; if (F.lane == NE) F.MISC[16 + NE] = (unsigned)total; }
    LDS_WAIT(); __syncthreads();
}
__device__ __forceinline__ void p8_combine(Frame& F) {
    const int gw = F.vcu * NWAVES + F.wave, NGW = F.G * NWAVES, lane = F.lane;
    const float* H = (const float*)(F.ws + WS_H); const bf16* Y = (const bf16*)(F.ws + WS_Y);
    for (int t = gw; t < T; t += NGW) {
        const GAS v4u* recp = (const GAS v4u*)((const v4u*)(F.ws + WS_TOK) + (size_t)t * 4);
        const GAS f32x4* hr = (const GAS f32x4*)(H + (size_t)t * D) + lane;
        f32x4 v[8];
#pragma unroll
        for (int j = 0; j < 8; ++j) v[j] = hr[64 * j];
#pragma unroll
        for (int k = 0; k < 4; ++k) { const v4u rec = recp[k]; const float gt = __uint_as_float(rec.z); const GAS v2u* yr = (const GAS v2u*)(Y + (size_t)rec.w * D) + lane;
#pragma unroll
            for (int j = 0; j < 8; ++j) { const v2u y = yr[64 * j]; v[j].x += gt * bf_lo(y.x); v[j].y += gt * bf_hi(y.x); v[j].z += gt * bf_lo(y.y); v[j].w += gt * bf_hi(y.y); } }
        float s = 0.f;
#pragma unroll
        for (int j = 0; j < 8; ++j) s += (v[j].x * v[j].x + v[j].y * v[j].y) + (v[j].z * v[j].z + v[j].w * v[j].w);
        const float rstd = 1.0f / sqrtf(wave_sum(s) * (1.f / D) + EPS);
        GAS f32x4* orow = (GAS f32x4*)(F.out + (size_t)t * D) + lane; const GAS f32x4* fw = (const GAS f32x4*)F.final_w + lane;
#pragma unroll
        for (int j = 0; j < 8; ++j) { const f32x4 g = fw[64 * j]; orow[64 * j] = v[j] * rstd * g; }
    }
}

#ifndef PG8_SP2
#define PG8_SP2 true
#endif
#ifndef PG8_ALIGN
#define PG8_ALIGN true
#endif
struct Args { const float* in[16]; float* out; unsigned char* ws; int ph_lo, ph_hi; };
__global__ void __launch_bounds__(NWAVES * 64, 2) enc_fwd(Args args) {
    extern __shared__ __attribute__((aligned(16))) unsigned char lds[];
    Frame F;
    F.lds = (LAS unsigned char*)lds;
    F.MISC = (volatile LAS unsigned*)(F.lds + MISC_OFF);
    F.tid = threadIdx.x; F.lane = F.tid & 63; F.wave = __builtin_amdgcn_readfirstlane(F.tid >> 6);
    F.G = gridDim.x; { const int bx = blockIdx.x; F.vcu = (F.G % 8 == 0) ? (bx % 8) * (F.G / 8) + bx / 8 : bx; }
    F.ws = args.ws; F.ctl = (gu32*)(args.ws + WS_CTL); F.out = args.out;
    F.x = args.in[0]; F.attn_norm_w = args.in[1]; F.w_in = args.in[2]; F.conv_w = args.in[3]; F.rpb = args.in[4]; F.aon_w = args.in[5]; F.con_w = args.in[6]; F.w_out = args.in[7];
    F.ffn_norm_w = args.in[8]; F.router_w = args.in[9]; F.router_b = args.in[10]; F.w_gu = args.in[11]; F.b_gu = args.in[12]; F.w_dn = args.in[13]; F.b_dn = args.in[14]; F.final_w = args.in[15];
    for (int u = F.tid; u < (LDS_BYTES - LDSCTL_OFF) / 4; u += NWAVES * 64) ((LAS unsigned*)(F.lds + LDSCTL_OFF))[u] = 0u;
    __syncthreads();
    XcdBarrier bar; bar.bar = (unsigned*)(F.ctl + CW_BAR); bar.x = 0; bar.st = nullptr;
    if (N_LAUNCHES == 1) bar = xcd_barrier_post((unsigned*)(F.ctl + CW_BAR), F.MISC + 8);
#define GRID_BAR() do { if (N_LAUNCHES == 1) xcd_barrier(bar); } while (0)
    const int lo = args.ph_lo, hi = args.ph_hi;
#define IN(k) (lo <= (k) && (k) < hi)
    bf16* const XN = (bf16*)(F.ws + WS_XN); bf16* const PROJ = (bf16*)(F.ws + WS_PROJ); bf16* const MIXED = (bf16*)(F.ws + WS_MIXED); float* const H = (float*)(F.ws + WS_H);
    bf16* const XG = (bf16*)(F.ws + WS_XG); bf16* const ACT = (bf16*)(F.ws + WS_ACT); bf16* const Y = (bf16*)(F.ws + WS_Y);
    const LAS int* const tbl = (const LAS int*)(F.lds + MISC_OFF + 64);

    if (IN(0)) { p0_prologue(F); GRID_BAR(); }
    if (IN(1)) {
        pg8::Gemm g{XN, (const bf16*)(F.ws + WS_WIN), T, NIN, D}; pg8::StaticOrder S; S.init(T, NIN, F.G, (int)blockIdx.x);
        pg8::EpiBf16<0> E{PROJ, NIN, nullptr, 0, 0, 1.f};
        pg8::gemm_phase<pg8::EpiBf16<0>, pg8::StaticOrder, PG8_ALIGN, PG8_SP2>(F.lds + RING_OFF, g, S, E);
        GRID_BAR();
    }
    if (IN(2)) {
        for (int u = F.vcu; u < NH * 32; u += F.G) na::attn_unit(u >> 5, u & 31, PROJ, (const bf16*)(F.ws + WS_BIASM), F.aon_w, MIXED, F.lds + RING_OFF);
        const int gw = F.vcu * NWAVES + F.wave, NGW = F.G * NWAVES;
        for (int it = gw; it < T / 4; it += NGW) na::conv_item(it, F.lane, PROJ, F.conv_w, F.con_w, MIXED);
        GRID_BAR();
    }
    if (IN(3)) {
        pg8::Gemm g{MIXED, (const bf16*)(F.ws + WS_WOUT), T, D, D}; pg8::StaticOrder S; S.init(T, D, F.G, (int)blockIdx.x);
        pg8::EpiRes E{F.x, H, D};
        pg8::gemm_phase<pg8::EpiRes, pg8::StaticOrder, PG8_ALIGN, PG8_SP2>(F.lds + RING_OFF, g, S, E);
        GRID_BAR();
    }
    if (IN(4)) {
        for (int tb = F.vcu; tb < T / 32; tb += F.G) route_tile(F, tb);
        __syncthreads();
        GRID_BAR();
    }
    if (IN(5)) { p5_dispatch(F); GRID_BAR(); }
    if (IN(6)) {
        moe_table_to_lds(F);
        pg8::Gemm g{XG, (const bf16*)(F.ws + WS_WGU), NSLOT, NE * 2 * FF, D}; pg8::MoeOrder S{tbl, 16, F.G, F.vcu};
        pg8::EpiSwiglu E{ACT, FF, F.b_gu};
        pg8::gemm_phase<pg8::EpiSwiglu, pg8::MoeOrder, PG8_ALIGN, PG8_SP2>(F.lds + RING_OFF, g, S, E);
        GRID_BAR();
    }
    if (IN(7)) {
        moe_table_to_lds(F);
        pg8::Gemm g{ACT, (const bf16*)(F.ws + WS_WDN), NSLOT, NE * D, FF}; pg8::MoeOrder S{tbl, 8, F.G, F.vcu};
        pg8::EpiBf16<0> E{Y, D, F.b_dn, D, 0, 1.f};
        pg8::gemm_phase<pg8::EpiBf16<0>, pg8::MoeOrder, PG8_ALIGN, PG8_SP2>(F.lds + RING_OFF, g, S, E);
        GRID_BAR();
    }
    if (IN(8)) p8_combine(F);
#undef IN
#undef GRID_BAR
}

extern "C" void kernel_launch(void* const* d_in, const int* in_sizes, int n_in, void* d_out, int out_size, void* d_ws, size_t ws_size, hipStream_t stream) {
    static int grid = 0;
    if (grid == 0) {
        if (n_in != 16 || in_sizes[0] != T * D || out_size != T * D || ws_size < WS_END) { fprintf(stderr, "kernel_launch: shape mismatch (n_in %d, in0 %d, out %d, ws %zu)\n", n_in, n_in > 0 ? in_sizes[0] : -1, out_size, ws_size); grid = -1; return; }
        int dev = 0, cus = 0, per_cu = 0;
        if (hipGetDevice(&dev) != hipSuccess || hipDeviceGetAttribute(&cus, hipDeviceAttributeMultiprocessorCount, dev) != hipSuccess) { grid = -1; return; }
        if (hipFuncSetAttribute((const void*)enc_fwd, hipFuncAttributeMaxDynamicSharedMemorySize, LDS_BYTES) != hipSuccess) { fprintf(stderr, "kernel_launch: hipFuncSetAttribute failed\n"); grid = -1; return; }
        if (hipOccupancyMaxActiveBlocksPerMultiprocessor(&per_cu, (const void*)enc_fwd, NWAVES * 64, LDS_BYTES) != hipSuccess || per_cu < 1) fprintf(stderr, "kernel_launch: occupancy query reports %d workgroups per CU\n", per_cu);
        (void)hipGetLastError();
        grid = cus;
    }
    if (grid < 0) return;
    if (hipMemsetAsync((char*)d_ws + WS_CTL, 0, CTL_ZERO_BYTES, stream) != hipSuccess) { fprintf(stderr, "kernel_launch: memset failed\n"); return; }
    Args a{};
    for (int i = 0; i < 16; ++i) a.in[i] = (const float*)d_in[i];
    a.out = (float*)d_out; a.ws = (unsigned char*)d_ws;
    for (int li = 0; li < N_LAUNCHES; ++li) {
        a.ph_lo = (N_LAUNCHES == 1) ? 0 : li; a.ph_hi = (N_LAUNCHES == 1) ? NPHASE : li + 1;
        hipLaunchKernelGGL(enc_fwd, dim3(grid), dim3(NWAVES * 64), LDS_BYTES, stream, a);
        const hipError_t le = hipPeekAtLastError();
        if (le != hipSuccess) { fprintf(stderr, "kernel_launch: launch %d failed: %s\n", li, hipGetErrorName(le)); break; }
    }
}
```

```cpp
#include <hip/hip_runtime.h>
#include <cstdio>
#include <cstdint>
namespace pg8 {
#define PG8_LAS __attribute__((address_space(3)))
typedef unsigned short bf16_t;
typedef short bf16x8 __attribute__((ext_vector_type(8)));
typedef float f32x4 __attribute__((ext_vector_type(4)));
typedef unsigned u32x4 __attribute__((ext_vector_type(4)));
typedef int v8i_t __attribute__((ext_vector_type(8)));
typedef int v4i_t __attribute__((ext_vector_type(4)));
__device__ __forceinline__ v8i_t cat8(bf16x8 a, bf16x8 b) { const v4i_t x = __builtin_bit_cast(v4i_t, a), y = __builtin_bit_cast(v4i_t, b); return (v8i_t){x[0], x[1], x[2], x[3], y[0], y[1], y[2], y[3]}; }
__device__ __forceinline__ void mfma_f8(float __attribute__((ext_vector_type(4)))& acc, v8i_t a, v8i_t b, int sc) {
    asm volatile("v_mfma_scale_f32_16x16x128_f8f6f4 %0, %1, %2, %0, %3, %3 op_sel_hi:[0,0,0]" : "+v"(acc) : "v"(a), "v"(b), "v"(sc)); }
constexpr int BM = 256, BK = 64, HALF = 128, HTB = HALF * BK * 2  , STAGE_BYTES = 8 * HTB, NXCD = 8, WGM = 8;

__host__ __device__ __forceinline__ int lds_byte(int r, int c) { const int st = (r >> 4) * 2 + (c >> 5), rr = r & 15, cc = c & 31, ob = rr * 64 + cc * 2; return st * 1024 + (ob ^ (((ob >> 9) & 1) << 5)); }
__host__ __device__ __forceinline__ void stage_rc(int b, int& R, int& C) { const int st = b / 1024, sb = b % 1024, swz = sb ^ (((sb >> 9) & 1) << 5); R = (st >> 1) * 16 + swz / 64; C = (st & 1) * 32 + (swz % 64) / 2; }
__host__ __device__ __forceinline__ int perm32(int rho) { const int n = rho >> 4, i = rho & 15; return 8 * (i >> 2) + 4 * n + (i & 3); }

struct Unit { int pm, pn; };
struct Gemm { const bf16_t* A; const bf16_t* Bt; int M, N, K; };


struct StaticOrder {
    int nM, nN, nwg, G, c;
    __host__ __device__ void init(int M, int N, int G_, int c_) { nM = M / BM; nN = N / BM; nwg = nM * nN; G = G_; c = c_; }
    __host__ __device__ bool next(int i, Unit& u) const {
        const long L = (long)i * G + c; if (L >= nwg) return false;
        int wgid = (int)L; { const int q = nwg / NXCD, r = nwg % NXCD, xcd = wgid % NXCD, off = wgid / NXCD; wgid = (xcd < r ? xcd * (q + 1) : r * (q + 1) + (xcd - r) * q) + off; }
        const int nig = WGM * nN, gid = wgid / nig, fm = gid * WGM, gsz = (nM - fm) < WGM ? (nM - fm) : WGM;
        u.pm = fm + ((wgid % nig) % gsz); u.pn = (wgid % nig) / gsz; return true;
    }
    __device__ __forceinline__ void a_ready(const Unit&) const {}
    __device__ __forceinline__ void done(const Unit&) const {}
};
struct MoeOrder {
    const PG8_LAS int* tb; int npn, G, c;
    __device__ __forceinline__ bool next(int i, Unit& u) const {
        const int L = i * G + c, total = tb[32] * npn; if (L >= total) return false;
        int e = 0;
        for (int k = 1; k < 32; ++k) e = (L >= tb[k] * npn) ? k : e;
        const int t0 = tb[e], mt = tb[e + 1] - t0, r = L - t0 * npn, pnl = r / mt, pml = r - pnl * mt;
        u.pm = __builtin_amdgcn_readfirstlane(t0 + pml); u.pn = __builtin_amdgcn_readfirstlane(e * npn + pnl); return true;
    }
    __device__ __forceinline__ void a_ready(const Unit&) const {}
    __device__ __forceinline__ void done(const Unit&) const {}
};
__device__ __forceinline__ unsigned cvt_pk_bf16(float lo, float hi) { unsigned r; asm volatile("v_cvt_pk_bf16_f32 %0, %1, %2" : "=v"(r) : "v"(lo), "v"(hi)); return r; }
typedef float f32x2 __attribute__((ext_vector_type(2)));
__device__ __forceinline__ f32x2 gelu_pk(f32x2 v) {
    const f32x2 av = __builtin_elementwise_abs(v), d = av * 0.2316418882f + 1.0f;
    f32x2 t; t.x = __builtin_amdgcn_rcpf(d.x); t.y = __builtin_amdgcn_rcpf(d.y);
    f32x2 q = t * 0.5307027145f + (-0.7265760135f); q = q * t + 0.7107068705f; q = q * t + (-0.142248368f); q = q * t + 0.127414796f; q = q * t;
    const f32x2 s = (v * v) * (-0.72134752044f);
    f32x2 e; e.x = __builtin_amdgcn_exp2f(s.x); e.y = __builtin_amdgcn_exp2f(s.y);
    const f32x2 m = v * (q * e), r = v - m;
    f32x2 o; o.x = v.x < 0.f ? m.x : r.x; o.y = v.y < 0.f ? m.y : r.y; return o;
}

template <int ACT  > struct EpiBf16 {
    static constexpr bool PERM = true, AFTER_DRAIN = false; static_assert(ACT == 0 || ACT == 1, "EpiBf16: ACT is 0 (none) or 1 (gelu_pk)");
    bf16_t* O; int ldc; const float* bias; int split_cols; size_t split_stride; float scale0;
    __device__ __forceinline__ void operator()(const f32x4 (&acc)[2][2][4][2], const Unit& u, int wr, int wc, int fr, int fq) const {
        const int row0 = u.pm * BM + wr * 64 + fr; int colt = u.pn * BM; bf16_t* base = O;
        float sc = 1.f; if (split_cols) { const int t = colt / split_cols; base += (size_t)t * split_stride; colt -= t * split_cols; if (t == 0) sc = scale0; }
        const int col0 = colt + wc * 32 + 8 * fq, bcol0 = u.pn * BM + wc * 32 + 8 * fq;
        f32x4 bv[2][2];
#pragma unroll
        for (int bj = 0; bj < 2; ++bj)
#pragma unroll
            for (int n = 0; n < 2; ++n) bv[bj][n] = bias ? *(const f32x4*)(bias + bcol0 + bj * HALF + 4 * n) : (f32x4){0.f, 0.f, 0.f, 0.f};
#pragma unroll
        for (int ai = 0; ai < 2; ++ai)
#pragma unroll
            for (int m = 0; m < 4; ++m) { bf16_t* rowp = base + (size_t)(row0 + ai * HALF + m * 16) * ldc + col0;
#pragma unroll
                for (int bj = 0; bj < 2; ++bj) { f32x4 v0 = acc[ai][bj][m][0] + bv[bj][0], v1 = acc[ai][bj][m][1] + bv[bj][1];
                    if (ACT == 1) { f32x2 a = gelu_pk((f32x2){v0[0], v0[1]}), b = gelu_pk((f32x2){v0[2], v0[3]}), c = gelu_pk((f32x2){v1[0], v1[1]}), d = gelu_pk((f32x2){v1[2], v1[3]});
                        v0 = (f32x4){a.x, a.y, b.x, b.y}; v1 = (f32x4){c.x, c.y, d.x, d.y}; }
                    v0 = v0 * sc; v1 = v1 * sc; u32x4 w; w.x = cvt_pk_bf16(v0[0], v0[1]); w.y = cvt_pk_bf16(v0[2], v0[3]); w.z = cvt_pk_bf16(v1[0], v1[1]); w.w = cvt_pk_bf16(v1[2], v1[3]);
                    *(u32x4*)(rowp + bj * HALF) = w; } }
    }
};


struct EpiRes {
    static constexpr bool PERM = false, AFTER_DRAIN = false;
    const float* base; float* out; int ldc;
    __device__ __forceinline__ void operator()(const f32x4 (&acc)[2][2][4][2], const Unit& u, int wr, int wc, int fr, int fq) const {
        const int row0 = u.pm * BM + wr * 64 + fr, col0 = u.pn * BM + wc * 32 + 4 * fq;
#pragma unroll
        for (int ai = 0; ai < 2; ++ai)
#pragma unroll
            for (int m = 0; m < 4; ++m) { const size_t off = (size_t)(row0 + ai * HALF + m * 16) * ldc + col0;
#pragma unroll
                for (int bj = 0; bj < 2; ++bj)
#pragma unroll
                    for (int n = 0; n < 2; ++n) { const f32x4 bs = *(const f32x4*)(base + off + bj * HALF + n * 16); *(f32x4*)(out + off + bj * HALF + n * 16) = bs + acc[ai][bj][m][n]; }
                asm volatile("" ::: "memory"); }
    }
};
struct EpiSwiglu {
    static constexpr bool PERM = true, AFTER_DRAIN = false;
    bf16_t* O; int ldc; const float* bias;
    __device__ __forceinline__ void operator()(const f32x4 (&acc)[2][2][4][2], const Unit& u, int wr, int wc, int fr, int fq) const {
        const int e = u.pn >> 4, pnl = u.pn & 15;
        const int row0 = u.pm * BM + wr * 64 + fr, col0 = pnl * HALF + wc * 32 + 8 * fq;
        const float* bg = bias + (size_t)e * 4096 + col0;
        const f32x4 bg0 = *(const f32x4*)(bg), bg1 = *(const f32x4*)(bg + 4), bl0 = *(const f32x4*)(bg + 2048), bl1 = *(const f32x4*)(bg + 2048 + 4);
#pragma unroll
        for (int ai = 0; ai < 2; ++ai)
#pragma unroll
            for (int m = 0; m < 4; ++m) { bf16_t* rowp = O + (size_t)(row0 + ai * HALF + m * 16) * ldc + col0;
                f32x4 g0 = acc[ai][0][m][0] + bg0, g1 = acc[ai][0][m][1] + bg1, l0 = acc[ai][1][m][0] + bl0, l1 = acc[ai][1][m][1] + bl1;
                float r[8];
#pragma unroll
                for (int j = 0; j < 8; ++j) { float g = j < 4 ? g0[j & 3] : g1[j & 3], l = j < 4 ? l0[j & 3] : l1[j & 3];
                    g = fminf(g, 7.0f); l = fminf(fmaxf(l, -7.0f), 7.0f);
                    const float sg = __builtin_amdgcn_rcpf(1.0f + __builtin_amdgcn_exp2f(g * (-1.702f * 1.4426950408889634f)));
                    r[j] = g * sg * (l + 1.0f); }
                u32x4 w; w.x = cvt_pk_bf16(r[0], r[1]); w.y = cvt_pk_bf16(r[2], r[3]); w.z = cvt_pk_bf16(r[4], r[5]); w.w = cvt_pk_bf16(r[6], r[7]);
                *(u32x4*)rowp = w; }
    }
};
__device__ __forceinline__ float clamp448(float v) { return __builtin_amdgcn_fmed3f(v, -448.0f, 448.0f); }
__device__ __forceinline__ unsigned pk4_fp8(float a, float b, float c, float d) {
    int r = 0; r = __builtin_amdgcn_cvt_pk_fp8_f32(clamp448(a), clamp448(b), r, false); r = __builtin_amdgcn_cvt_pk_fp8_f32(clamp448(c), clamp448(d), r, true); return (unsigned)r; }
struct EpiSwigluF8 {
    static constexpr bool PERM = true, AFTER_DRAIN = false;
    unsigned char* O; int ldc; const float* bias; float inv, oscale;
    __device__ __forceinline__ void operator()(const f32x4 (&acc)[2][2][4][2], const Unit& u, int wr, int wc, int fr, int fq) const {
        const int e = u.pn >> 4, pnl = u.pn & 15;
        const int row0 = u.pm * BM + wr * 64 + fr, col0 = pnl * HALF + wc * 32 + 8 * fq;
        const float* bg = bias + (size_t)e * 4096 + col0;
        const f32x4 bg0 = *(const f32x4*)(bg), bg1 = *(const f32x4*)(bg + 4), bl0 = *(const f32x4*)(bg + 2048), bl1 = *(const f32x4*)(bg + 2048 + 4);
#pragma unroll
        for (int ai = 0; ai < 2; ++ai)
#pragma unroll
            for (int m = 0; m < 4; ++m) { unsigned char* rowp = O + (size_t)(row0 + ai * HALF + m * 16) * ldc + col0;
                f32x4 g0 = acc[ai][0][m][0] * inv + bg0, g1 = acc[ai][0][m][1] * inv + bg1, l0 = acc[ai][1][m][0] * inv + bl0, l1 = acc[ai][1][m][1] * inv + bl1;
                float r[8];
#pragma unroll
                for (int j = 0; j < 8; ++j) { float g = j < 4 ? g0[j & 3] : g1[j & 3], l = j < 4 ? l0[j & 3] : l1[j & 3];
                    g = fminf(g, 7.0f); l = fminf(fmaxf(l, -7.0f), 7.0f);
                    const float sg = __builtin_amdgcn_rcpf(1.0f + __builtin_amdgcn_exp2f(g * (-1.702f * 1.4426950408889634f)));
                    r[j] = g * sg * (l + 1.0f) * oscale; }
                typedef unsigned u32x2 __attribute__((ext_vector_type(2)));
                u32x2 w; w.x = pk4_fp8(r[0], r[1], r[2], r[3]); w.y = pk4_fp8(r[4], r[5], r[6], r[7]);
                *(u32x2*)rowp = w; }
    }
};
struct EpiBf16s {
    static constexpr bool PERM = true, AFTER_DRAIN = false;
    bf16_t* O; int ldc; const float* bias; int ntile; float sc;
    __device__ __forceinline__ void operator()(const f32x4 (&acc)[2][2][4][2], const Unit& u, int wr, int wc, int fr, int fq) const {
        const int pnl = u.pn % ntile;
        const int row0 = u.pm * BM + wr * 64 + fr, col0 = pnl * BM + wc * 32 + 8 * fq, bcol0 = u.pn * BM + wc * 32 + 8 * fq;
        f32x4 bv[2][2];
#pragma unroll
        for (int bj = 0; bj < 2; ++bj)
#pragma unroll
            for (int n = 0; n < 2; ++n) bv[bj][n] = *(const f32x4*)(bias + bcol0 + bj * HALF + 4 * n);
#pragma unroll
        for (int ai = 0; ai < 2; ++ai)
#pragma unroll
            for (int m = 0; m < 4; ++m) { bf16_t* rowp = O + (size_t)(row0 + ai * HALF + m * 16) * ldc + col0;
#pragma unroll
                for (int bj = 0; bj < 2; ++bj) { const f32x4 v0 = acc[ai][bj][m][0] * sc + bv[bj][0], v1 = acc[ai][bj][m][1] * sc + bv[bj][1];
                    u32x4 w; w.x = cvt_pk_bf16(v0[0], v0[1]); w.y = cvt_pk_bf16(v0[2], v0[3]); w.z = cvt_pk_bf16(v1[0], v1[1]); w.w = cvt_pk_bf16(v1[2], v1[3]);
                    *(u32x4*)(rowp + bj * HALF) = w; } }
    }
};
template <class Epi, class Sched, bool ALIGN_EPI = false, bool SP2 = false, bool F8 = false>
__device__ __forceinline__ void gemm_phase(PG8_LAS unsigned char* lds, const Gemm g, const Sched& S, const Epi& E) {
    const int tid = threadIdx.x, wid = __builtin_amdgcn_readfirstlane(tid >> 6), lane = tid & 63, wr = wid >> 2, wc = wid & 3, fr = lane & 15, fq = lane >> 4;
    const int K = g.K, nt = K / BK;
    int f8scale = 0x7F7F7F7F; asm volatile("" : "+v"(f8scale));
    unsigned voffA[2], voffB[2];
#pragma unroll
    for (int i = 0; i < 2; ++i) { int R, C; stage_rc(tid * 16 + i * 8192, R, C); const int Rb = Epi::PERM ? ((R & ~31) + perm32(R & 31)) : R;
        voffA[i] = (unsigned)(R * K + C) * 2u; voffB[i] = (unsigned)(Rb * K + C) * 2u; }
    const size_t kstep = (size_t)(BK * 2);
    const size_t hstep = (size_t)HALF * K * 2;
    const size_t tstep = 2 * hstep;
    const unsigned ldsw = (unsigned)wid * 1024u;
    const int aoff = lds_byte(wr * 64 + fr, fq * 8), boff = lds_byte(wc * 32 + fr, fq * 8);
#define PG8_SA(b, h) (((b) * 2 + (h)) * HTB)
#define PG8_SB(b, h) ((4 + (b) * 2 + (h)) * HTB)
#define PG8_STAGE(bufoff, gbase, voff) do { _Pragma("unroll") for (int _i = 0; _i < 2; ++_i) \
        __builtin_amdgcn_global_load_lds((const unsigned*)((const char*)(gbase) + (voff)[_i]), (PG8_LAS unsigned*)(lds + (bufoff) + ldsw + _i * 8192), 16, 0, 0); } while (0)
#define PG8_LDA(dst, b, h) do { _Pragma("unroll") for (int m = 0; m < 4; ++m) _Pragma("unroll") for (int k = 0; k < 2; ++k) dst[m][k] = *(const PG8_LAS bf16x8*)(lds + PG8_SA(b, h) + aoff + m * 2048 + k * 1024); } while (0)
#define PG8_LDB(dst, b, h) do { _Pragma("unroll") for (int n = 0; n < 2; ++n) _Pragma("unroll") for (int k = 0; k < 2; ++k) dst[n][k] = *(const PG8_LAS bf16x8*)(lds + PG8_SB(b, h) + boff + n * 2048 + k * 1024); } while (0)
#define PG8_MMA(ai, bj, At, Bt) do { __builtin_amdgcn_s_setprio(1); _Pragma("unroll") for (int m = 0; m < 4; ++m) _Pragma("unroll") for (int n = 0; n < 2; ++n) { \
        if constexpr (F8) mfma_f8(acc[ai][bj][m][n], cat8(Bt[n][0], Bt[n][1]), cat8(At[m][0], At[m][1]), f8scale); \
        else { _Pragma("unroll") for (int k = 0; k < 2; ++k) acc[ai][bj][m][n] = __builtin_amdgcn_mfma_f32_16x16x32_bf16(Bt[n][k], At[m][k], acc[ai][bj][m][n], 0, 0, 0); } } \
        __builtin_amdgcn_s_setprio(0); } while (0)
#define PG8_WAIT_V(n) asm volatile("s_waitcnt vmcnt(" #n ")" ::: "memory")
#define PG8_WAIT_L(n) asm volatile("s_waitcnt lgkmcnt(" #n ")" ::: "memory")
#define PG8_BAR __builtin_amdgcn_s_barrier()
#define PG8_SCHED __builtin_amdgcn_sched_barrier(0)
    Unit cur, nxt; int ui = 0;
    if (!S.next(0, cur)) return;
    f32x4 acc[2][2][4][2];
#pragma unroll
    for (int a = 0; a < 2; ++a)
#pragma unroll
        for (int b = 0; b < 2; ++b)
#pragma unroll
            for (int m = 0; m < 4; ++m)
#pragma unroll
                for (int n = 0; n < 2; ++n) acc[a][b][m][n] = (f32x4){0.f, 0.f, 0.f, 0.f};
    bf16x8 At[4][2], B0[2][2], B1[2][2];
    const char* cA = (const char*)g.A + (size_t)cur.pm * tstep; const char* cB = (const char*)g.Bt + (size_t)cur.pn * tstep;
    S.a_ready(cur);
    if constexpr (SP2) {
        PG8_STAGE(PG8_SB(0, 0), cB, voffB); PG8_STAGE(PG8_SB(0, 1), cB + hstep, voffB); PG8_STAGE(PG8_SA(0, 0), cA, voffA); PG8_STAGE(PG8_SA(0, 1), cA + hstep, voffA);
        if (wr == 1) PG8_BAR;
        PG8_WAIT_V(2); PG8_BAR;
        PG8_STAGE(PG8_SB(1, 0), cB + kstep, voffB); PG8_STAGE(PG8_SA(1, 0), cA + kstep, voffA); PG8_STAGE(PG8_SB(1, 1), cB + hstep + kstep, voffB);
        PG8_WAIT_V(6); PG8_BAR;
    } else {
        PG8_STAGE(PG8_SB(0, 0), cB, voffB); PG8_STAGE(PG8_SA(0, 0), cA, voffA); PG8_STAGE(PG8_SB(0, 1), cB + hstep, voffB); PG8_STAGE(PG8_SA(0, 1), cA + hstep, voffA);
        if (wr == 1) PG8_BAR;
        PG8_WAIT_V(4); PG8_BAR;
        PG8_STAGE(PG8_SB(1, 0), cB + kstep, voffB); PG8_STAGE(PG8_SA(1, 0), cA + kstep, voffA); PG8_STAGE(PG8_SB(1, 1), cB + hstep + kstep, voffB);
        PG8_WAIT_V(6); PG8_BAR;
    }
    for (;;) {
        const bool has_next = S.next(ui + 1, nxt);
        const char* nA = has_next ? (const char*)g.A + (size_t)nxt.pm * tstep : cA; const char* nB = has_next ? (const char*)g.Bt + (size_t)nxt.pn * tstep : cB;
        for (int t = 0; t < nt; t += 2) {
            const bool last = (t == nt - 2);
            const char* a1 = cA + (size_t)(t + 1) * kstep;
            const char* a2 = last ? nA : cA + (size_t)(t + 2) * kstep; const char* b2 = last ? nB : cB + (size_t)(t + 2) * kstep;
            const char* a3 = a2 + kstep; const char* b3 = b2 + kstep;
            if (last && has_next) S.a_ready(nxt);
            if constexpr (SP2) {
            PG8_LDB(B0, 0, 0); PG8_LDB(B1, 0, 1); PG8_SCHED; PG8_LDA(At, 0, 0); PG8_STAGE(PG8_SA(1, 1), a1 + hstep, voffA);
            PG8_WAIT_V(8); PG8_WAIT_L(0); PG8_BAR; PG8_MMA(0, 0, At, B0); PG8_MMA(0, 1, At, B1); PG8_BAR; PG8_SCHED;
            PG8_LDA(At, 0, 1); PG8_STAGE(PG8_SB(0, 0), b2, voffB); PG8_STAGE(PG8_SB(0, 1), b2 + hstep, voffB); PG8_STAGE(PG8_SA(0, 0), a2, voffA);
            PG8_WAIT_V(8); PG8_WAIT_L(0); PG8_BAR; PG8_MMA(1, 0, At, B0); PG8_MMA(1, 1, At, B1); PG8_BAR; PG8_SCHED;
            PG8_LDB(B0, 1, 0); PG8_LDB(B1, 1, 1); PG8_SCHED; PG8_LDA(At, 1, 0); PG8_STAGE(PG8_SA(0, 1), a2 + hstep, voffA);
            PG8_WAIT_V(8); PG8_WAIT_L(0); PG8_BAR; PG8_MMA(0, 0, At, B0); PG8_MMA(0, 1, At, B1); PG8_BAR; PG8_SCHED;
            PG8_LDA(At, 1, 1); PG8_STAGE(PG8_SB(1, 0), b3, voffB); PG8_STAGE(PG8_SB(1, 1), b3 + hstep, voffB); PG8_STAGE(PG8_SA(1, 0), a3, voffA);
            PG8_WAIT_V(8); PG8_WAIT_L(0); PG8_BAR; PG8_MMA(1, 0, At, B0); PG8_MMA(1, 1, At, B1); PG8_BAR; PG8_SCHED;
            } else {
            PG8_LDB(B0, 0, 0); PG8_SCHED; PG8_LDA(At, 0, 0); PG8_STAGE(PG8_SA(1, 1), a1 + hstep, voffA);
            PG8_WAIT_L(8); PG8_BAR; PG8_WAIT_L(0); PG8_MMA(0, 0, At, B0); PG8_BAR; PG8_SCHED;
            PG8_LDB(B1, 0, 1); PG8_STAGE(PG8_SB(0, 0), b2, voffB);
            PG8_BAR; PG8_WAIT_L(0); PG8_MMA(0, 1, At, B1); PG8_BAR;
            PG8_LDA(At, 0, 1); PG8_STAGE(PG8_SA(0, 0), a2, voffA);
            PG8_BAR; PG8_WAIT_L(0); PG8_MMA(1, 0, At, B0); PG8_BAR; PG8_SCHED;
            PG8_STAGE(PG8_SB(0, 1), b2 + hstep, voffB);
            PG8_WAIT_V(6); PG8_BAR; PG8_MMA(1, 1, At, B1); PG8_BAR;
            PG8_LDB(B0, 1, 0); PG8_SCHED; PG8_LDA(At, 1, 0); PG8_STAGE(PG8_SA(0, 1), a2 + hstep, voffA);
            PG8_WAIT_L(8); PG8_BAR; PG8_WAIT_L(0); PG8_MMA(0, 0, At, B0); PG8_BAR; PG8_SCHED;
            PG8_LDB(B1, 1, 1); PG8_STAGE(PG8_SB(1, 0), b3, voffB);
            PG8_BAR; PG8_WAIT_L(0); PG8_MMA(0, 1, At, B1); PG8_BAR;
            PG8_LDA(At, 1, 1); PG8_STAGE(PG8_SA(1, 0), a3, voffA);
            PG8_BAR; PG8_WAIT_L(0); PG8_MMA(1, 0, At, B0); PG8_BAR; PG8_SCHED;
            PG8_STAGE(PG8_SB(1, 1), b3 + hstep, voffB);
            PG8_WAIT_V(6); PG8_BAR; PG8_MMA(1, 1, At, B1); PG8_BAR;
            }
        }
        if constexpr (F8) asm volatile("s_nop 15\n\ts_nop 15" ::: "memory");
        if constexpr (ALIGN_EPI) { if (wr == 0) PG8_BAR; }
        if constexpr (!Epi::AFTER_DRAIN) { E(acc, cur, wr, wc, fr, fq); S.done(cur); }
        if (!has_next) break;
#pragma unroll
        for (int a = 0; a < 2; ++a)
#pragma unroll
            for (int b = 0; b < 2; ++b)
#pragma unroll
                for (int m = 0; m < 4; ++m)
#pragma unroll
                    for (int n = 0; n < 2; ++n) acc[a][b][m][n] = (f32x4){0.f, 0.f, 0.f, 0.f};
        cur = nxt; cA = nA; cB = nB; ++ui;
        if constexpr (ALIGN_EPI) { if (wr == 1) PG8_BAR; }
    }
    PG8_WAIT_V(0);
    if constexpr (!ALIGN_EPI) { if (wr == 0) PG8_BAR; }
    PG8_BAR;
    if constexpr (Epi::AFTER_DRAIN) { E.fused(acc, cur, wr, wc, fr, fq, lds, wid, lane); S.done(cur); }
#undef PG8_SA
#undef PG8_SB
#undef PG8_STAGE
#undef PG8_LDA
#undef PG8_LDB
#undef PG8_MMA
#undef PG8_WAIT_V
#undef PG8_WAIT_L
#undef PG8_BAR
#undef PG8_SCHED
}
}

constexpr int NWAVES = 8;
#ifndef MK_N_LAUNCHES
#define MK_N_LAUNCHES 1
#endif
constexpr int NPHASE = 9;
constexpr int N_LAUNCHES = MK_N_LAUNCHES;
static_assert(N_LAUNCHES == 1 || N_LAUNCHES == NPHASE, "MK_N_LAUNCHES is 1 or 9");

constexpr int T = 8192, D = 2048, NIN = 6144, AW = 1024, CW = 1024, NH = 8, HD = 128, GW = 64, GR = 128;
constexpr int NE = 32, TOPK = 4, FF = 2048;
constexpr float EPS = 1e-5f;
constexpr float WSCALE = 512.f, ASCALE = 16.f, ACTSCALE = 4.f;
constexpr int NSLOT = T * TOPK + NE * 256;

constexpr size_t MiB = 1u << 20;
constexpr size_t WS_CTL = 0, CTL_ZERO_BYTES = 1 * MiB;
constexpr size_t WS_RWT   = 1 * MiB;
constexpr size_t WS_BIASM = 2 * MiB;
constexpr size_t WS_TOK   = 3 * MiB;
constexpr size_t WS_HIST  = 3 * MiB + 640 * 1024;
constexpr size_t WS_WIN   = 4 * MiB;
constexpr size_t WS_WOUT  = 28 * MiB;
constexpr size_t WS_XN    = 36 * MiB;
constexpr size_t WS_PROJ  = 68 * MiB;
constexpr size_t WS_MIXED = 164 * MiB;
constexpr size_t WS_H     = 196 * MiB;
constexpr size_t WS_HN    = 260 * MiB;
constexpr size_t WS_XG    = 292 * MiB;
constexpr size_t WS_ACT   = 452 * MiB;
constexpr size_t WS_Y     = 612 * MiB;
constexpr size_t WS_WGU   = 772 * MiB;
constexpr size_t WS_WDN   = 1284 * MiB;
constexpr size_t WS_END   = 1540 * MiB;
static_assert((size_t)NSLOT * D * 2 <= 160 * MiB, "slot matrices");
constexpr int CW_TMO = 0, CW_CODE = 1;
constexpr int CW_CNT = 64;
constexpr int CW_BAR = 4096;

constexpr int RING_OFF = 0, RING_BYTES = 131072;
constexpr int P0SCR_BYTES = 8 * 17408;
constexpr int LDSCTL_OFF = P0SCR_BYTES, MISC_OFF = LDSCTL_OFF + 320;
constexpr int LDS_BYTES = 147456;
static_assert(MISC_OFF + 4 * 64 + 2048 <= LDS_BYTES && P0SCR_BYTES >= RING_BYTES, "LDS map");

#define GAS __attribute__((address_space(1)))
#define LAS __attribute__((address_space(3)))
typedef unsigned short bf16;
typedef unsigned v4u __attribute__((ext_vector_type(4)));
typedef unsigned v2u __attribute__((ext_vector_type(2)));
typedef float f32x4 __attribute__((ext_vector_type(4)));
typedef float f32x16 __attribute__((ext_vector_type(16)));
typedef short bf16x8 __attribute__((ext_vector_type(8)));
typedef short s16x4 __attribute__((ext_vector_type(4)));
typedef GAS unsigned gu32;
#define RLX_AGENT __ATOMIC_RELAXED, __HIP_MEMORY_SCOPE_AGENT
#define LDS_WAIT() asm volatile("s_waitcnt lgkmcnt(0)" ::: "memory")
#define VM_WAIT() asm volatile("s_waitcnt vmcnt(0)" ::: "memory")
__device__ __forceinline__ unsigned pk2(float lo, float hi) { unsigned r; asm volatile("v_cvt_pk_bf16_f32 %0, %1, %2" : "=v"(r) : "v"(lo), "v"(hi)); return r; }
__device__ __forceinline__ float bf_lo(unsigned w) { return __uint_as_float(w << 16); }
__device__ __forceinline__ float bf_hi(unsigned w) { return __uint_as_float(w & 0xffff0000u); }
#define XB_TMO      128
#define XB_XCNT(j)  (256  + 64 * (j))
#define XB_XSUB(j)  (1280 + 64 * (j))
#define XB_XGEN(j)  (2304 + 64 * (j))
#define XB_TOP      3328
#define XB_TOPGEN   3392
#define XCD_BAR_WORDS 3456
#define XB_SPIN_CAP (1u << 18)

__device__ __forceinline__ unsigned xb_ld(unsigned* p)              { return __hip_atomic_load(p, __ATOMIC_RELAXED, __HIP_MEMORY_SCOPE_AGENT); }
__device__ __forceinline__ unsigned xb_add(unsigned* p, unsigned v) { return __hip_atomic_fetch_add(p, v, __ATOMIC_RELAXED, __HIP_MEMORY_SCOPE_AGENT); }
__device__ __forceinline__ unsigned xb_xcc_id() { return (unsigned)__builtin_amdgcn_s_getreg((3 << 11) | 20) & 0xFu; }
#define XB_SPIN(cond, bar) do { unsigned _sp = 0; while (cond) { __builtin_amdgcn_s_sleep(1); \
    if ((++_sp & 255u) == 0u) { if (xb_ld(&(bar)[XB_TMO])) break; if (_sp > XB_SPIN_CAP) { atomicAdd(&(bar)[XB_TMO], 1u); break; } } } } while (0)

struct XcdBarrier {
    unsigned* bar; unsigned x;
    volatile LAS unsigned* st;
};

__device__ __forceinline__ XcdBarrier xcd_barrier_post(unsigned* bar, volatile LAS unsigned* st) {
    XcdBarrier b; b.bar = bar; b.x = xb_xcc_id(); b.st = st;
    if (threadIdx.x == 0) (void)xb_add(&bar[XB_XCNT(b.x)], 1u);
    return b;
}
__device__ __forceinline__ void xcd_barrier_complete(unsigned* bar, unsigned x, unsigned& nloc, unsigned& nx) {
    const unsigned G = gridDim.x * gridDim.y * gridDim.z;
    unsigned sum, cnt, mine, sp = 0u;
    for (;;) {
        sum = 0u; cnt = 0u; mine = 0u;
#pragma unroll
        for (unsigned j = 0; j < 16; ++j) { const unsigned c = xb_ld(&bar[XB_XCNT(j)]); sum += c; cnt += (c > 0u) ? 1u : 0u; mine = (j == x) ? c : mine; }
        if (sum == G) break;
        __builtin_amdgcn_s_sleep(1);
        if ((++sp & 255u) == 0u) { if (xb_ld(&bar[XB_TMO])) break; if (sp > XB_SPIN_CAP) { atomicAdd(&bar[XB_TMO], 1u); break; } }
    }
    nloc = mine > 0u ? mine : 1u; nx = cnt > 0u ? cnt : 1u;
}

__device__ __forceinline__ void xcd_barrier(const XcdBarrier& b) {
    asm volatile("s_waitcnt vmcnt(0)" ::: "memory");
    __syncthreads();
    if (threadIdx.x == 0) {
        unsigned* bar = b.bar;
        __builtin_amdgcn_s_waitcnt(0);
        unsigned nloc = b.st[0], nx = b.st[1];
        if (nloc == 0u) { xcd_barrier_complete(bar, b.x, nloc, nx); b.st[0] = nloc; b.st[1] = nx; }
        const unsigned old = xb_add(&bar[XB_XSUB(b.x)], 1u);
        const unsigned gen = old / nloc;
        if (old + 1u == (gen + 1u) * nloc) {
            __builtin_amdgcn_fence(__ATOMIC_RELEASE, "agent");
            asm volatile("s_waitcnt vmcnt(0)" ::: "memory");
            const unsigned og = xb_add(&bar[XB_TOP], 1u);
            const unsigned tg = og / nx;
            if (og + 1u == (tg + 1u) * nx) xb_add(&bar[XB_TOPGEN], 1u);
            else XB_SPIN(xb_ld(&bar[XB_TOPGEN]) == tg, bar);
            __builtin_amdgcn_fence(__ATOMIC_ACQUIRE, "agent");
            xb_add(&bar[XB_XGEN(b.x)], 1u);
            asm volatile("s_waitcnt vmcnt(0)" ::: "memory");
        } else {
            XB_SPIN(xb_ld(&bar[XB_XGEN(b.x)]) == gen, bar);
            __builtin_amdgcn_fence(__ATOMIC_ACQUIRE, "agent");
            asm volatile("s_waitcnt vmcnt(0)" ::: "memory");
        }
    }
    __syncthreads();
}

struct Frame {
    LAS unsigned char* lds;
    volatile LAS unsigned* MISC;
    gu32* ctl;
    int tid, lane, wave;
    int vcu, G;
    const float *x, *attn_norm_w, *w_in, *conv_w, *rpb, *aon_w, *con_w, *w_out, *ffn_norm_w, *router_w, *router_b, *w_gu, *b_gu, *w_dn, *b_dn, *final_w;
    float* out;
    unsigned char* ws;
};
__device__ __forceinline__ float wave_sum(float v) {
#pragma unroll
    for (int o = 1; o < 64; o <<= 1) v += __shfl_xor(v, o);
    return v;
}
__device__ __forceinline__ float wave_max(float v) {
#pragma unroll
    for (int o = 1; o < 64; o <<= 1) v = fmaxf(v, __shfl_xor(v, o));
    return v;
}

template <bool GU>
__device__ __forceinline__ void p0_transpose_item(const float* W, int K, int N, bf16* WT, LAS float* scr, int item, int lane) {
    const int nblk = N / 32, kb = item / nblk, nb = item % nblk, k0 = 64 * kb, n0 = 32 * nb;
#pragma unroll 8
    for (int i = 0; i < 32; ++i) { const int kk = 2 * i + (lane >> 5); scr[kk * 33 + (lane & 31)] = W[(size_t)(k0 + kk) * N + n0 + (lane & 31)]; }
    LDS_WAIT(); asm volatile("" ::: "memory");
    const int c = lane & 7;
    const int nd0 = GU ? (((n0 & 2047) >> 7) * 256 + (n0 >> 11) * 128 + (n0 & 127)) : n0;
#pragma unroll
    for (int j = 0; j < 4; ++j) { const int n = (lane >> 3) + 8 * j; const LAS float* s = scr + (8 * c) * 33 + n;
        v4u o; o.x = pk2(s[0 * 33], s[1 * 33]); o.y = pk2(s[2 * 33], s[3 * 33]); o.z = pk2(s[4 * 33], s[5 * 33]); o.w = pk2(s[6 * 33], s[7 * 33]);
        *(GAS v4u*)(WT + (size_t)(nd0 + n) * K + k0 + 8 * c) = o; }
    LDS_WAIT(); asm volatile("" ::: "memory");
}
__device__ __forceinline__ void rms_row_to_bf16(int lane, const float* xrow, const float* w, bf16* orow) {
    const GAS f32x4* xr = (const GAS f32x4*)xrow + lane; const GAS f32x4* wr = (const GAS f32x4*)w + lane;
    f32x4 v[8]; float s = 0.f;
#pragma unroll
    for (int j = 0; j < 8; ++j) { v[j] = xr[64 * j]; s += (v[j].x * v[j].x + v[j].y * v[j].y) + (v[j].z * v[j].z + v[j].w * v[j].w); }
    const float rstd = 1.0f / sqrtf(wave_sum(s) * (1.f / D) + EPS);
    GAS v2u* o8 = (GAS v2u*)orow + lane;
#pragma unroll
    for (int j = 0; j < 8; ++j) { const f32x4 g = wr[64 * j]; v2u o; o.x = pk2(v[j].x * rstd * g.x, v[j].y * rstd * g.y); o.y = pk2(v[j].z * rstd * g.z, v[j].w * rstd * g.w); o8[64 * j] = o; }
}
struct P0Item { const float* src; unsigned char* dst; int N; };
__device__ __forceinline__ P0Item p0_f8_decode(Frame& F, int it) {
    constexpr int I_GU = (D / 64) * (2 * FF / 64), I_DN = (FF / 64) * (D / 64);
    P0Item r;
    if (it < NE * I_GU) { const int e = it / I_GU, li = it % I_GU, nblk = 2 * FF / 64, kb = li / nblk, nb = li % nblk, n0 = nb * 64;
        const int nd0 = ((n0 & 2047) >> 7) * 256 + (n0 >> 11) * 128 + (n0 & 127);
        r.src = F.w_gu + (size_t)e * D * 2 * FF + (size_t)(kb * 64) * (2 * FF) + n0; r.dst = F.ws + WS_WGU + ((size_t)e * 2 * FF + nd0) * D + kb * 64; r.N = 2 * FF; }
    else { it -= NE * I_GU; const int e = it / I_DN, li = it % I_DN, nblk = D / 64, kb = li / nblk, nb = li % nblk, n0 = nb * 64;
        r.src = F.w_dn + (size_t)e * FF * D + (size_t)(kb * 64) * D + n0; r.dst = F.ws + WS_WDN + ((size_t)e * D + n0) * FF + kb * 64; r.N = D; }
    return r;
}
__device__ __forceinline__ void p0_f8_load(const P0Item& d, int lane, f32x4 (&v)[16]) {
    const GAS f32x4* p = (const GAS f32x4*)(d.src + (size_t)(lane >> 4) * d.N + (lane & 15) * 4);
#pragma unroll
    for (int i = 0; i < 16; ++i) v[i] = *(const GAS f32x4*)((const GAS float*)p + (size_t)(4 * i) * d.N);
}
__device__ __forceinline__ void p0_f8_process(const P0Item& d, int lane, const f32x4 (&v)[16], LAS float* scr) {
    const int kr = lane >> 4, nc = (lane & 15) * 4;
#pragma unroll
    for (int i = 0; i < 16; ++i) *(LAS f32x4*)(scr + (4 * i + kr) * 68 + nc) = v[i];
    LDS_WAIT(); asm volatile("" ::: "memory");
#pragma unroll
    for (int p = 0; p < 4; ++p) { const int n = (p & 1) * 32 + (lane & 31), c = (p >> 1) * 2 + (lane >> 5);
        const LAS float* s = scr + (16 * c) * 68 + n; float t[16];
#pragma unroll
        for (int kk = 0; kk < 16; ++kk) t[kk] = s[kk * 68] * WSCALE;
        v4u o; o.x = pg8::pk4_fp8(t[0], t[1], t[2], t[3]); o.y = pg8::pk4_fp8(t[4], t[5], t[6], t[7]); o.z = pg8::pk4_fp8(t[8], t[9], t[10], t[11]); o.w = pg8::pk4_fp8(t[12], t[13], t[14], t[15]);
        *(GAS v4u*)(d.dst + (size_t)n * D + 16 * c) = o; }
    LDS_WAIT(); asm volatile("" ::: "memory");
}
__device__ __forceinline__ void p0_convert_experts(Frame& F, int first_wave, int wave_stride_unused) {
    LAS float* scr = (LAS float*)(F.lds + RING_OFF + F.wave * 17408);
    const int gw = F.vcu * NWAVES + F.wave, NGW = F.G * NWAVES;
    constexpr int NITEMS = NE * (D / 64) * (2 * FF / 64) + NE * (FF / 64) * (D / 64);
    f32x4 va[16], vb[16];
    int it = gw;
    P0Item da, db;
    if (it < NITEMS) { da = p0_f8_decode(F, it); p0_f8_load(da, F.lane, va); }
    while (it < NITEMS) {
        const int i2 = it + NGW;
        if (i2 < NITEMS) { db = p0_f8_decode(F, i2); p0_f8_load(db, F.lane, vb); }
        p0_f8_process(da, F.lane, va, scr);
        if (i2 >= NITEMS) break;
        const int i3 = i2 + NGW;
        if (i3 < NITEMS) { da = p0_f8_decode(F, i3); p0_f8_load(da, F.lane, va); }
        p0_f8_process(db, F.lane, vb, scr);
        it = i3;
    }
}
__device__ __forceinline__ void p0_prologue(Frame& F) {
    LAS float* scr = (LAS float*)(F.lds + RING_OFF + F.wave * 17408);
    const int gw = F.vcu * NWAVES + F.wave, NGW = F.G * NWAVES;
    constexpr int I_IN = (D / 64) * (NIN / 32), I_OUT = (D / 64) * (D / 32);
    bf16* WIN = (bf16*)(F.ws + WS_WIN); bf16* WOUT = (bf16*)(F.ws + WS_WOUT);
    for (int m = gw; m < T; m += NGW) rms_row_to_bf16(F.lane, F.x + (size_t)m * D, F.attn_norm_w, (bf16*)(F.ws + WS_XN) + (size_t)m * D);
    {
        float* RWT = (float*)(F.ws + WS_RWT);
        for (int i = (int)blockIdx.x * 512 + F.tid; i < NE * D; i += F.G * 512) { const int e = i / D, k = i % D; RWT[i] = F.ffn_norm_w[k] * F.router_w[(size_t)k * NE + e]; }
        bf16* BM_ = (bf16*)(F.ws + WS_BIASM);
        for (int i = (int)blockIdx.x * 512 + F.tid; i < NH * 15 * 64 * 64; i += F.G * 512) {
            const int c = i & 63, kc = (i >> 6) & 63, hd = i >> 12;
            int cs = c - 8; cs = cs < 0 ? 0 : (cs > 48 ? 48 : cs);
            const bool in = (kc >= cs) && (kc < cs + 16);
            const float v = in ? F.rpb[(size_t)hd * 31 + (kc - c + 15)] * 11.313708498984761f : -1e30f;
            BM_[i] = (bf16)(pk2(v, v) & 0xffffu);
        }
    }
    for (int it = gw; it < I_IN + I_OUT; it += NGW) {
        if (it < I_IN) p0_transpose_item<false>(F.w_in, D, NIN, WIN, scr, it, F.lane);
        else p0_transpose_item<false>(F.w_out, D, D, WOUT, scr, it - I_IN, F.lane);
    }
    p0_convert_experts(F, 0, 1);
}
namespace na {
constexpr int LDP = NIN;
constexpr float SCALE = 0.088388347648318440f, CL2 = SCALE * 1.4426950408889634f, THR = 8.f;
constexpr int SHM_V = 64 * 128 * 2, SHM_K = 64 * 128 * 2;
constexpr int OFF_V = 0, OFF_K = 2 * SHM_V, OFF_WS = 2 * SHM_V + 2 * SHM_K;
#define KSWZ(row, colB) ((row) * 256 + ((colB) ^ (((row) & 7) << 4)))
#define SBAR() __builtin_amdgcn_sched_barrier(0)
__device__ __forceinline__ int crow(int r, int hi) { return (r & 3) + 8 * (r >> 2) + 4 * hi; }
__device__ __forceinline__ int v_st(int k, int c) { const int kk = (k & ~0xC) | ((k & 4) << 1) | ((k & 8) >> 1); return ((kk >> 3) * 4 + (c >> 5)) * 512 + ((kk & 7) * 32 + (c & 31)) * 2; }
__device__ __forceinline__ int v_rd_base(int lane) { return ((lane & 3) << 3) | (((lane >> 2) & 3) << 6) | (((lane >> 4) & 1) << 5) | (((lane >> 5) & 1) << 8); }
constexpr int v_rd_off(int d0, int ks, int half) { return d0 * 512 + ks * 4096 + half * 2048; }
template <int OFF> __device__ __forceinline__ s16x4 tr_read(int vb) {
    s16x4 r; asm volatile("ds_read_b64_tr_b16 %0, %1 offset:%2" : "=&v"(r) : "v"(vb), "i"(OFF) : "memory"); return r;
}
template <int D0> __device__ __forceinline__ void pv_one(f32x16& od, int vb, bf16x8 pa0, bf16x8 pa1, bf16x8 pa2, bf16x8 pa3) {
    const s16x4 l0 = tr_read<v_rd_off(D0, 0, 0)>(vb), h0 = tr_read<v_rd_off(D0, 0, 1)>(vb), l1 = tr_read<v_rd_off(D0, 1, 0)>(vb), h1 = tr_read<v_rd_off(D0, 1, 1)>(vb);
    const s16x4 l2 = tr_read<v_rd_off(D0, 2, 0)>(vb), h2 = tr_read<v_rd_off(D0, 2, 1)>(vb), l3 = tr_read<v_rd_off(D0, 3, 0)>(vb), h3 = tr_read<v_rd_off(D0, 3, 1)>(vb);
    asm volatile("s_waitcnt lgkmcnt(0)" ::: "memory"); SBAR();
#define PK(L, H) (bf16x8){L[0], L[1], L[2], L[3], H[0], H[1], H[2], H[3]}
    od = __builtin_amdgcn_mfma_f32_32x32x16_bf16(pa0, PK(l0, h0), od, 0, 0, 0);
    od = __builtin_amdgcn_mfma_f32_32x32x16_bf16(pa1, PK(l1, h1), od, 0, 0, 0);
    od = __builtin_amdgcn_mfma_f32_32x32x16_bf16(pa2, PK(l2, h2), od, 0, 0, 0);
    od = __builtin_amdgcn_mfma_f32_32x32x16_bf16(pa3, PK(l3, h3), od, 0, 0, 0);
#undef PK
}
__device__ __forceinline__ void attn_unit(int h, int rb, const bf16* __restrict__ proj, const bf16* __restrict__ biasm, const float* __restrict__ nw, bf16* __restrict__ mixed, LAS unsigned char* lds) {
    const int tid = threadIdx.x, wid = __builtin_amdgcn_readfirstlane(tid >> 6), lane = tid & 63, r32 = lane & 31, hi = lane >> 5;
    const int r0 = rb * 4, gr = r0 + (wid >> 1), c0 = (wid & 1) * 32;
    int rs = gr - 4; rs = rs < 0 ? 0 : (rs > GR - 8 ? GR - 8 : rs);
    int ks = r0 - 4; ks = ks < 0 ? 0 : (ks > GR - 8 ? GR - 8 : ks);
    int ke = r0 + 3 - 4; ke = (ke < 0 ? 0 : (ke > GR - 8 ? GR - 8 : ke)) + 8;
    const int NT = ke - ks;
    LAS unsigned char* V_lds = lds + OFF_V; LAS unsigned char* K_lds = lds + OFF_K;
    LAS float* ws = (LAS float*)(lds + OFF_WS) + wid * 64; LAS float* li_l = ws; LAS float* al_l = ws + 32;
    float m_reg = -1e30f, l_reg = 0.f; f32x16 o[4] = {}; bf16x8 qr[8];
    const bf16* Qw = proj + (size_t)(gr * GW + c0 + r32) * LDP + h * HD + hi * 8;
#pragma unroll
    for (int d0 = 0; d0 < 8; ++d0) qr[d0] = *(const bf16x8*)(Qw + d0 * 16);
    bf16x8 qe[2];
#pragma unroll
    for (int s = 0; s < 2; ++s)
#pragma unroll
        for (int j = 0; j < 8; ++j) qe[s][j] = (16 * s + 8 * hi + j == r32) ? (short)0x3F80 : (short)0;
    const int sr = tid >> 4, sc = (tid & 15) * 8, vst0 = v_st(sr, sc), vst1 = v_st(32 + sr, sc);
    const int vb0 = (int)(uintptr_t)V_lds + v_rd_base(lane);
    const bf16* Kh = proj + AW + h * HD; const bf16* Vh = proj + 2 * AW + h * HD;
    bf16x8 vs0, vs1, ks0, ks1;
#define SLOAD(tok0) do { vs0 = *(const bf16x8*)(Vh + (size_t)((tok0) + sr) * LDP + sc); vs1 = *(const bf16x8*)(Vh + (size_t)((tok0) + 32 + sr) * LDP + sc); \
        ks0 = *(const bf16x8*)(Kh + (size_t)((tok0) + sr) * LDP + sc); ks1 = *(const bf16x8*)(Kh + (size_t)((tok0) + 32 + sr) * LDP + sc); } while (0)
#define SWRITE(b) do { *(LAS bf16x8*)(V_lds + (b) * SHM_V + vst0) = vs0; *(LAS bf16x8*)(V_lds + (b) * SHM_V + vst1) = vs1; const int kc_ = sc * 2; \
        *(LAS bf16x8*)(K_lds + (b) * SHM_K + KSWZ(sr, kc_)) = ks0; *(LAS bf16x8*)(K_lds + (b) * SHM_K + KSWZ(32 + sr, kc_)) = ks1; } while (0)
    SLOAD(ks * GW); SWRITE(0); __syncthreads();
    for (int j = 0; j < NT; ++j) {
        const int kr = ks + j, b = j & 1;
        const bool active = (kr >= rs) && (kr < rs + 8);
        bf16x8 ae00, ae01, ae10, ae11;
        if (active) { const bf16* bp = biasm + ((size_t)((h * 15 + (kr - gr + 7)) * 64 + r32) * 64 + c0 + 8 * hi);
            ae00 = *(const bf16x8*)(bp); ae01 = *(const bf16x8*)(bp + 16); ae10 = *(const bf16x8*)(bp + 32 * 64); ae11 = *(const bf16x8*)(bp + 32 * 64 + 16); }
        if (j + 1 < NT) SLOAD((kr + 1) * GW);
        if (active) {
            f32x16 p0 = {}, p1 = {};
            const LAS unsigned char* Kb = K_lds + b * SHM_K;
#pragma unroll
            for (int d0 = 0; d0 < 8; ++d0) { const int cb = (d0 * 16 + hi * 8) * 2;
                const bf16x8 b0 = *(const LAS bf16x8*)(Kb + KSWZ(r32, cb)), b1 = *(const LAS bf16x8*)(Kb + KSWZ(32 + r32, cb));
                p0 = __builtin_amdgcn_mfma_f32_32x32x16_bf16(b0, qr[d0], p0, 0, 0, 0);
                p1 = __builtin_amdgcn_mfma_f32_32x32x16_bf16(b1, qr[d0], p1, 0, 0, 0); }
            p0 = __builtin_amdgcn_mfma_f32_32x32x16_bf16(ae00, qe[0], p0, 0, 0, 0); p0 = __builtin_amdgcn_mfma_f32_32x32x16_bf16(ae01, qe[1], p0, 0, 0, 0);
            p1 = __builtin_amdgcn_mfma_f32_32x32x16_bf16(ae10, qe[0], p1, 0, 0, 0); p1 = __builtin_amdgcn_mfma_f32_32x32x16_bf16(ae11, qe[1], p1, 0, 0, 0);
            float pmax = p0[0];
#pragma unroll
            for (int r = 1; r < 16; ++r) pmax = fmaxf(pmax, p0[r]);
#pragma unroll
            for (int r = 0; r < 16; ++r) pmax = fmaxf(pmax, p1[r]);
            { auto rr = __builtin_amdgcn_permlane32_swap(__float_as_uint(pmax), __float_as_uint(pmax), false, false); pmax = fmaxf(__uint_as_float(rr[0]), __uint_as_float(rr[1])); }
            float mn, alpha;
            if (__all(pmax - m_reg <= THR / SCALE)) { mn = m_reg; alpha = 1.f; }
            else { mn = fmaxf(m_reg, pmax); alpha = __builtin_amdgcn_exp2f((m_reg - mn) * CL2); m_reg = mn; }
            const float mnC = -mn * CL2;
#pragma unroll
            for (int r = 0; r < 16; ++r) { p0[r] = __builtin_amdgcn_exp2f(fmaf(p0[r], CL2, mnC)); p1[r] = __builtin_amdgcn_exp2f(fmaf(p1[r], CL2, mnC)); }
            float ps = 0.f;
#pragma unroll
            for (int r = 0; r < 16; ++r) ps += p0[r] + p1[r];
            { auto rr = __builtin_amdgcn_permlane32_swap(__float_as_uint(ps), __float_as_uint(ps), false, false); ps = __uint_as_float(rr[0]) + __uint_as_float(rr[1]); }
            l_reg = l_reg * alpha + ps;
            if (__any(alpha < 1.f)) { if (hi == 0) al_l[r32] = alpha; LDS_WAIT();
#pragma unroll
                for (int d = 0; d < 4; ++d)
#pragma unroll
                    for (int r = 0; r < 16; ++r) o[d][r] *= al_l[crow(r, hi)];
            }
            bf16x8 pa0, pa1, pa2, pa3;
#define PK4(P, BASE, OUT) do { unsigned a0 = pk2(P[BASE + 0], P[BASE + 1]), a1 = pk2(P[BASE + 2], P[BASE + 3]); \
    unsigned b0_ = pk2(P[BASE + 4], P[BASE + 5]), b1_ = pk2(P[BASE + 6], P[BASE + 7]); \
    auto r0_ = __builtin_amdgcn_permlane32_swap(a0, b0_, false, false); auto r1_ = __builtin_amdgcn_permlane32_swap(a1, b1_, false, false); \
    v4u w_ = {r0_[0], r1_[0], r0_[1], r1_[1]}; OUT = __builtin_bit_cast(bf16x8, w_); } while (0)
            PK4(p0, 0, pa0); PK4(p0, 8, pa1); PK4(p1, 0, pa2); PK4(p1, 8, pa3);
#undef PK4
            const int vb = vb0 + b * SHM_V;
            pv_one<0>(o[0], vb, pa0, pa1, pa2, pa3); pv_one<1>(o[1], vb, pa0, pa1, pa2, pa3); pv_one<2>(o[2], vb, pa0, pa1, pa2, pa3); pv_one<3>(o[3], vb, pa0, pa1, pa2, pa3);
        }
        if (j + 1 < NT) SWRITE(b ^ 1);
        __syncthreads();
    }
#undef SLOAD
#undef SWRITE
    if (hi == 0) li_l[r32] = l_reg; LDS_WAIT();
    float rli[16], ss[16];
#pragma unroll
    for (int r = 0; r < 16; ++r) { rli[r] = __builtin_amdgcn_rcpf(li_l[crow(r, hi)]); float a = 0.f;
#pragma unroll
        for (int d = 0; d < 4; ++d) { o[d][r] *= rli[r]; a += o[d][r] * o[d][r]; }
        ss[r] = a; }
#pragma unroll
    for (int r = 0; r < 16; ++r) {
#pragma unroll
        for (int s = 1; s < 32; s <<= 1) ss[r] += __shfl_xor(ss[r], s);
        ss[r] = 1.0f / sqrtf(ss[r] * (1.f / HD) + EPS); }
    float nwv[4];
#pragma unroll
    for (int d = 0; d < 4; ++d) nwv[d] = nw[h * HD + d * 32 + r32];
    bf16* Ow = mixed + (size_t)(gr * GW + c0) * D + h * HD + r32;
#pragma unroll
    for (int r = 0; r < 16; ++r) { const int orow = crow(r, hi);
#pragma unroll
        for (int d = 0; d < 4; ++d) { const float v = o[d][r] * ss[r] * nwv[d]; Ow[(size_t)orow * D + d * 32] = (bf16)(pk2(v, v) & 0xffffu); } }
    __syncthreads();
}
#undef KSWZ
#undef SBAR
__device__ __forceinline__ void conv_item(int item, int lane, const bf16* __restrict__ proj, const float* __restrict__ cw, const float* __restrict__ nw, bf16* __restrict__ mixed) {
    const int t0 = item * 4;
#pragma unroll 1
    for (int cc = 0; cc < 2; ++cc) {
        const int ch = cc * 512 + 8 * lane;
        float w0[8], w1[8], w2[8], g[8];
#pragma unroll
        for (int i = 0; i < 8; ++i) { w0[i] = cw[ch + i]; w1[i] = cw[CW + ch + i]; w2[i] = cw[2 * CW + ch + i]; g[i] = nw[ch + i]; }
        float z[6][8];
#pragma unroll
        for (int tt = 0; tt < 6; ++tt) { const int t = t0 + tt - 1;
            if (t >= 0 && t < T) { const v4u uu = *(const v4u*)(proj + (size_t)t * LDP + 3 * AW + ch), cv = *(const v4u*)(proj + (size_t)t * LDP + 3 * AW + 2 * CW + ch);
#pragma unroll
                for (int q = 0; q < 4; ++q) { z[tt][2 * q] = bf_lo(uu[q]) * bf_lo(cv[q]); z[tt][2 * q + 1] = bf_hi(uu[q]) * bf_hi(cv[q]); } }
            else {
#pragma unroll
                for (int i = 0; i < 8; ++i) z[tt][i] = 0.f; } }
#pragma unroll
        for (int tt = 0; tt < 4; ++tt) { const int t = t0 + tt;
            const v4u bb = *(const v4u*)(proj + (size_t)t * LDP + 3 * AW + CW + ch);
            float y[8], s = 0.f;
#pragma unroll
            for (int q = 0; q < 4; ++q) { const float b0 = bf_lo(bb[q]), b1 = bf_hi(bb[q]); const int i0 = 2 * q, i1 = 2 * q + 1;
                y[i0] = b0 * (w0[i0] * z[tt][i0] + w1[i0] * z[tt + 1][i0] + w2[i0] * z[tt + 2][i0]);
                y[i1] = b1 * (w0[i1] * z[tt][i1] + w1[i1] * z[tt + 1][i1] + w2[i1] * z[tt + 2][i1]);
                s += y[i0] * y[i0] + y[i1] * y[i1]; }
#pragma unroll
            for (int o = 1; o < 16; o <<= 1) s += __shfl_xor(s, o);
            const float rstd = 1.0f / sqrtf(s * (1.f / 128.f) + EPS);
            v4u ov; ov.x = pk2(y[0] * rstd * g[0], y[1] * rstd * g[1]); ov.y = pk2(y[2] * rstd * g[2], y[3] * rstd * g[3]); ov.z = pk2(y[4] * rstd * g[4], y[5] * rstd * g[5]); ov.w = pk2(y[6] * rstd * g[6], y[7] * rstd * g[7]);
            *(v4u*)(mixed + (size_t)t * D + AW + ch) = ov; }
    }
}
}

__device__ __forceinline__ void route_tile(Frame& F, int tb) {
    const int lane = F.lane, w = F.wave;
    const float* H = (const float*)(F.ws + WS_H); unsigned char* HN = F.ws + WS_HN; const float* RWT = (const float*)(F.ws + WS_RWT);
    LAS f32x4* tab = (LAS f32x4*)(F.lds + RING_OFF);
    volatile LAS unsigned* lc = F.MISC + 64;
    if (F.tid < NE) lc[F.tid] = 0u;
    f32x4 v[4][8]; float lg[4];
#pragma unroll
    for (int i = 0; i < 4; ++i) { const int t = tb * 32 + w * 4 + i; const GAS f32x4* xr = (const GAS f32x4*)(H + (size_t)t * D) + lane; float s = 0.f;
#pragma unroll
        for (int j = 0; j < 8; ++j) { v[i][j] = xr[64 * j]; s += (v[i][j].x * v[i][j].x + v[i][j].y * v[i][j].y) + (v[i][j].z * v[i][j].z + v[i][j].w * v[i][j].w); }
        const float rstd = 1.0f / sqrtf(wave_sum(s) * (1.f / D) + EPS);
        GAS unsigned* o4 = (GAS unsigned*)(HN + (size_t)t * D) + lane; const GAS f32x4* fw = (const GAS f32x4*)F.ffn_norm_w + lane;
#pragma unroll
        for (int j = 0; j < 8; ++j) { v[i][j] = v[i][j] * rstd; const f32x4 g = fw[64 * j] * ASCALE; o4[64 * j] = pg8::pk4_fp8(v[i][j].x * g.x, v[i][j].y * g.y, v[i][j].z * g.z, v[i][j].w * g.w); }
        lg[i] = 0.f; }
#pragma unroll 1
    for (int chunk = 0; chunk < 2; ++chunk) {
        __syncthreads();
        { const GAS f32x4* src = (const GAS f32x4*)(RWT + (size_t)chunk * 16 * D);
#pragma unroll
          for (int q = 0; q < 16; ++q) tab[q * 512 + F.tid] = src[q * 512 + F.tid]; }
        __syncthreads();
#pragma unroll 1
        for (int el = 0; el < 16; ++el) {
            float a[4] = {0.f, 0.f, 0.f, 0.f};
#pragma unroll
            for (int j = 0; j < 8; ++j) { const f32x4 wv = tab[el * 512 + 64 * j + lane];
#pragma unroll
                for (int i = 0; i < 4; ++i) a[i] += (v[i][j].x * wv.x + v[i][j].y * wv.y) + (v[i][j].z * wv.z + v[i][j].w * wv.w); }
#pragma unroll
            for (int i = 0; i < 4; ++i) { const float s = wave_sum(a[i]); lg[i] = (lane == chunk * 16 + el) ? s : lg[i]; }
        }
    }
    const float rb = lane < NE ? F.router_b[lane] : 0.f;
#pragma unroll
    for (int i = 0; i < 4; ++i) { const int t = tb * 32 + w * 4 + i;
        float val = lane < NE ? lg[i] + rb : -3.0e38f;
        float tv[4]; int te[4];
#pragma unroll
        for (int k = 0; k < 4; ++k) { const float m = wave_max(val); const unsigned long long bal = __ballot(val == m); const int idx = __builtin_ctzll(bal); tv[k] = m; te[k] = idx; if (lane == idx) val = -3.0e38f; }
        float ex[4], den = 0.f;
#pragma unroll
        for (int k = 0; k < 4; ++k) { ex[k] = __expf(tv[k] - tv[0]); den += ex[k]; }
        const float inv = 1.0f / den;
        if (lane < 4) { const int e = lane == 0 ? te[0] : lane == 1 ? te[1] : lane == 2 ? te[2] : te[3]; const float gt = (lane == 0 ? ex[0] : lane == 1 ? ex[1] : lane == 2 ? ex[2] : ex[3]) * inv;
            const unsigned pos = __hip_atomic_fetch_add((LAS unsigned*)(F.lds + MISC_OFF + 256) + e, 1u, __ATOMIC_RELAXED, __HIP_MEMORY_SCOPE_WORKGROUP);
            v4u rec; rec.x = (unsigned)e; rec.y = pos; rec.z = __float_as_uint(gt); rec.w = 0u;
            *(GAS v4u*)((v4u*)(F.ws + WS_TOK) + (size_t)t * 4 + lane) = rec; }
    }
    LDS_WAIT(); __syncthreads();
    if (F.tid < NE) ((GAS int*)(F.ws + WS_HIST))[tb * NE + F.tid] = (int)lc[F.tid];
    __syncthreads();
}
__device__ __forceinline__ void expert_tables(Frame& F, int tb, int& tot, int& pre, int& tbase) {
    const int lane = F.lane, w = F.wave; const GAS int* HIST = (const GAS int*)(F.ws + WS_HIST);
    volatile LAS int* part = (volatile LAS int*)(F.MISC + 128);
    int t = 0, p = 0;
    if (lane < NE) {
#pragma unroll 8
        for (int b = 32 * w; b < 32 * w + 32; ++b) { const int c = HIST[b * NE + lane]; t += c; p += (b < tb) ? c : 0; } }
    __syncthreads();
    if (lane < NE) { part[w * 64 + lane] = t; part[w * 64 + 32 + lane] = p; }
    LDS_WAIT(); __syncthreads();
    tot = 0; pre = 0;
    if (lane < NE) {
#pragma unroll
        for (int q = 0; q < 8; ++q) { tot += part[q * 64 + lane]; pre += part[q * 64 + 32 + lane]; } }
    const int mt = (tot + 255) >> 8;
    int incl = mt;
#pragma unroll
    for (int o = 1; o < 32; o <<= 1) { const int y = __shfl_up(incl, o); if ((lane & 31) >= o) incl += y; }
    const int total = __shfl(incl, 31);
    tbase = lane == 32 ? total : incl - mt;
}
__device__ __forceinline__ void p5_dispatch_tile(Frame& F, int tb) {
    int tot, pre, tbase; expert_tables(F, tb, tot, pre, tbase);
    const int sb = tbase * 256 + pre, lane = F.lane, w = F.wave;
    const unsigned char* HN = F.ws + WS_HN; unsigned char* XG = F.ws + WS_XG;
#pragma unroll
    for (int i = 0; i < 4; ++i) { const int t = tb * 32 + w * 4 + i;
        GAS v4u* recp = (GAS v4u*)((v4u*)(F.ws + WS_TOK) + (size_t)t * 4);
        const v4u r0 = recp[0], r1 = recp[1], r2 = recp[2], r3 = recp[3];
        const int s0 = __shfl(sb, (int)r0.x) + (int)r0.y, s1 = __shfl(sb, (int)r1.x) + (int)r1.y, s2 = __shfl(sb, (int)r2.x) + (int)r2.y, s3 = __shfl(sb, (int)r3.x) + (int)r3.y;
        if (lane < 4) { const int s = lane == 0 ? s0 : lane == 1 ? s1 : lane == 2 ? s2 : s3; ((GAS unsigned*)(recp + lane))[3] = (unsigned)s; }
        const GAS v4u* src = (const GAS v4u*)(HN + (size_t)t * D) + lane;
        const v4u a0 = src[0], a1 = src[64];
        ((GAS v4u*)(XG + (size_t)s0 * D) + lane)[0] = a0; ((GAS v4u*)(XG + (size_t)s0 * D) + lane)[64] = a1;
        ((GAS v4u*)(XG + (size_t)s1 * D) + lane)[0] = a0; ((GAS v4u*)(XG + (size_t)s1 * D) + lane)[64] = a1;
        ((GAS v4u*)(XG + (size_t)s2 * D) + lane)[0] = a0; ((GAS v4u*)(XG + (size_t)s2 * D) + lane)[64] = a1;
        ((GAS v4u*)(XG + (size_t)s3 * D) + lane)[0] = a0; ((GAS v4u*)(XG + (size_t)s3 * D) + lane)[64] = a1; }
}
__device__ __forceinline__ void moe_table_to_lds(Frame& F) {
    int tot, pre, tbase; expert_tables(F, -1, tot, pre, tbase);
    if (F.wave == 0 && F.lane <= NE) F.MISC[16 + F.lane] = (unsigned)tbase;
    LDS_WAIT(); __syncthreads();
}
__device__ __forceinline__ void p8_combine(Frame& F) {
    const int gw = F.vcu * NWAVES + F.wave, NGW = F.G * NWAVES, lane = F.lane;
    const float* H = (const float*)(F.ws + WS_H); const bf16* Y = (const bf16*)(F.ws + WS_Y);
    for (int t = gw; t < T; t += NGW) {
        const GAS v4u* recp = (const GAS v4u*)((const v4u*)(F.ws + WS_TOK) + (size_t)t * 4);
        const GAS f32x4* hr = (const GAS f32x4*)(H + (size_t)t * D) + lane;
        f32x4 v[8];
#pragma unroll
        for (int j = 0; j < 8; ++j) v[j] = hr[64 * j];
#pragma unroll
        for (int k = 0; k < 4; ++k) { const v4u rec = recp[k]; const float gt = __uint_as_float(rec.z); const GAS v2u* yr = (const GAS v2u*)(Y + (size_t)rec.w * D) + lane;
#pragma unroll
            for (int j = 0; j < 8; ++j) { const v2u y = yr[64 * j]; v[j].x += gt * bf_lo(y.x); v[j].y += gt * bf_hi(y.x); v[j].z += gt * bf_lo(y.y); v[j].w += gt * bf_hi(y.y); } }
        float s = 0.f;
#pragma unroll
        for (int j = 0; j < 8; ++j) s += (v[j].x * v[j].x + v[j].y * v[j].y) + (v[j].z * v[j].z + v[j].w * v[j].w);
        const float rstd = 1.0f / sqrtf(wave_sum(s) * (1.f / D) + EPS);
        GAS f32x4* orow = (GAS f32x4*)(F.out + (size_t)t * D) + lane; const GAS f32x4* fw = (const GAS f32x4*)F.final_w + lane;
#pragma unroll
        for (int j = 0; j < 8; ++j) { const f32x4 g = fw[64 * j]; orow[64 * j] = v[j] * rstd * g; }
    }
}

#ifndef PG8_SP2
#define PG8_SP2 true
#endif
#ifndef PG8_ALIGN
#define PG8_ALIGN true
#endif
struct Args { const float* in[16]; float* out; unsigned char* ws; int ph_lo, ph_hi; };
__global__ void __launch_bounds__(NWAVES * 64, 2) enc_fwd(Args args) {
    extern __shared__ __attribute__((aligned(16))) unsigned char lds[];
    Frame F;
    F.lds = (LAS unsigned char*)lds;
    F.MISC = (volatile LAS unsigned*)(F.lds + MISC_OFF);
    F.tid = threadIdx.x; F.lane = F.tid & 63; F.wave = __builtin_amdgcn_readfirstlane(F.tid >> 6);
    F.G = gridDim.x; { const int bx = blockIdx.x; F.vcu = (F.G % 8 == 0) ? (bx % 8) * (F.G / 8) + bx / 8 : bx; }
    F.ws = args.ws; F.ctl = (gu32*)(args.ws + WS_CTL); F.out = args.out;
    F.x = args.in[0]; F.attn_norm_w = args.in[1]; F.w_in = args.in[2]; F.conv_w = args.in[3]; F.rpb = args.in[4]; F.aon_w = args.in[5]; F.con_w = args.in[6]; F.w_out = args.in[7];
    F.ffn_norm_w = args.in[8]; F.router_w = args.in[9]; F.router_b = args.in[10]; F.w_gu = args.in[11]; F.b_gu = args.in[12]; F.w_dn = args.in[13]; F.b_dn = args.in[14]; F.final_w = args.in[15];
    for (int u = F.tid; u < (LDS_BYTES - LDSCTL_OFF) / 4; u += NWAVES * 64) ((LAS unsigned*)(F.lds + LDSCTL_OFF))[u] = 0u;
    __syncthreads();
    XcdBarrier bar; bar.bar = (unsigned*)(F.ctl + CW_BAR); bar.x = 0; bar.st = nullptr;
    if (N_LAUNCHES == 1) bar = xcd_barrier_post((unsigned*)(F.ctl + CW_BAR), F.MISC + 8);
#define GRID_BAR() do { if (N_LAUNCHES == 1) xcd_barrier(bar); } while (0)
    const int lo = args.ph_lo, hi = args.ph_hi;
#ifndef PHASE_MASK
#define PHASE_MASK 0x1ff
#endif
#define IN(k) (lo <= (k) && (k) < hi && ((PHASE_MASK >> (k)) & 1))
#ifndef REP_PHASE
#define REP_PHASE -1
#endif
#define NREP(k) ((REP_PHASE) == (k) ? 2 : 1)
    bf16* const XN = (bf16*)(F.ws + WS_XN); bf16* const PROJ = (bf16*)(F.ws + WS_PROJ); bf16* const MIXED = (bf16*)(F.ws + WS_MIXED); float* const H = (float*)(F.ws + WS_H);
    bf16* const XG = (bf16*)(F.ws + WS_XG); bf16* const ACT = (bf16*)(F.ws + WS_ACT); bf16* const Y = (bf16*)(F.ws + WS_Y);
    const LAS int* const tbl = (const LAS int*)(F.lds + MISC_OFF + 64);

    if (IN(0)) { _Pragma("unroll") for (int rep = 0; rep < NREP(0); ++rep) { p0_prologue(F); GRID_BAR(); } }
    if (IN(1)) { _Pragma("unroll") for (int rep = 0; rep < NREP(1); ++rep) {
        pg8::Gemm g{XN, (const bf16*)(F.ws + WS_WIN), T, NIN, D}; pg8::StaticOrder S; S.init(T, NIN, F.G, (int)blockIdx.x);
        pg8::EpiBf16<0> E{PROJ, NIN, nullptr, 0, 0, 1.f};
        pg8::gemm_phase<pg8::EpiBf16<0>, pg8::StaticOrder, PG8_ALIGN, PG8_SP2>(F.lds + RING_OFF, g, S, E);
        GRID_BAR();
    } }
    if (IN(2)) { _Pragma("unroll") for (int rep = 0; rep < NREP(2); ++rep) {
        for (int u = F.vcu; u < NH * 32; u += F.G) na::attn_unit(u >> 5, u & 31, PROJ, (const bf16*)(F.ws + WS_BIASM), F.aon_w, MIXED, F.lds + RING_OFF);
        const int gw = F.vcu * NWAVES + F.wave, NGW = F.G * NWAVES;
        for (int it = gw; it < T / 4; it += NGW) na::conv_item(it, F.lane, PROJ, F.conv_w, F.con_w, MIXED);
        GRID_BAR();
    } }
    if (IN(3)) { _Pragma("unroll") for (int rep = 0; rep < NREP(3); ++rep) {
        pg8::Gemm g{MIXED, (const bf16*)(F.ws + WS_WOUT), T, D, D}; pg8::StaticOrder S; S.init(T, D, F.G, (int)blockIdx.x);
        pg8::EpiRes E{F.x, H, D};
        pg8::gemm_phase<pg8::EpiRes, pg8::StaticOrder, PG8_ALIGN, PG8_SP2>(F.lds + RING_OFF, g, S, E);
        GRID_BAR();
    } }
    if (IN(4)) {
        for (int tb = F.vcu; tb < T / 32; tb += F.G) route_tile(F, tb);
        __syncthreads();
        GRID_BAR();
    }
    if (IN(5)) { _Pragma("unroll") for (int rep = 0; rep < NREP(5); ++rep) { for (int tb = F.vcu; tb < T / 32; tb += F.G) p5_dispatch_tile(F, tb); GRID_BAR(); } }
    if (IN(6)) { _Pragma("unroll") for (int rep = 0; rep < NREP(6); ++rep) {
        moe_table_to_lds(F);
        pg8::Gemm g{XG, (const bf16*)(F.ws + WS_WGU), NSLOT, NE * 2 * FF, D / 2}; pg8::MoeOrder S{tbl, 16, F.G, F.vcu};
        pg8::EpiSwigluF8 E{(unsigned char*)ACT, FF, F.b_gu, 1.0f / (WSCALE * ASCALE), ACTSCALE};
        pg8::gemm_phase<pg8::EpiSwigluF8, pg8::MoeOrder, PG8_ALIGN, PG8_SP2, true>(F.lds + RING_OFF, g, S, E);
        GRID_BAR();
    } }
    if (IN(7)) { _Pragma("unroll") for (int rep = 0; rep < NREP(7); ++rep) {
        moe_table_to_lds(F);
        pg8::Gemm g{ACT, (const bf16*)(F.ws + WS_WDN), NSLOT, NE * D, FF / 2}; pg8::MoeOrder S{tbl, 8, F.G, F.vcu};
        pg8::EpiBf16s E{Y, D, F.b_dn, 8, 1.0f / (WSCALE * ACTSCALE)};
        pg8::gemm_phase<pg8::EpiBf16s, pg8::MoeOrder, PG8_ALIGN, PG8_SP2, true>(F.lds + RING_OFF, g, S, E);
        GRID_BAR();
    } }
    if (IN(8)) { _Pragma("unroll") for (int rep = 0; rep < NREP(8); ++rep) { p8_combine(F); } }
#undef IN
#undef GRID_BAR
}

extern "C" void kernel_launch(void* const* d_in, const int* in_sizes, int n_in, void* d_out, int out_size, void* d_ws, size_t ws_size, hipStream_t stream) {
    static int grid = 0;
    if (grid == 0) {
        if (n_in != 16 || in_sizes[0] != T * D || out_size != T * D || ws_size < WS_END) { fprintf(stderr, "kernel_launch: shape mismatch (n_in %d, in0 %d, out %d, ws %zu)\n", n_in, n_in > 0 ? in_sizes[0] : -1, out_size, ws_size); grid = -1; return; }
        int dev = 0, cus = 0, per_cu = 0;
        if (hipGetDevice(&dev) != hipSuccess || hipDeviceGetAttribute(&cus, hipDeviceAttributeMultiprocessorCount, dev) != hipSuccess) { grid = -1; return; }
        if (hipFuncSetAttribute((const void*)enc_fwd, hipFuncAttributeMaxDynamicSharedMemorySize, LDS_BYTES) != hipSuccess) { fprintf(stderr, "kernel_launch: hipFuncSetAttribute failed\n"); grid = -1; return; }
        if (hipOccupancyMaxActiveBlocksPerMultiprocessor(&per_cu, (const void*)enc_fwd, NWAVES * 64, LDS_BYTES) != hipSuccess || per_cu < 1) fprintf(stderr, "kernel_launch: occupancy query reports %d workgroups per CU\n", per_cu);
        (void)hipGetLastError();
        grid = cus;
    }
    if (grid < 0) return;
    if (hipMemsetAsync((char*)d_ws + WS_CTL, 0, CTL_ZERO_BYTES, stream) != hipSuccess) { fprintf(stderr, "kernel_launch: memset failed\n"); return; }
    Args a{};
    for (int i = 0; i < 16; ++i) a.in[i] = (const float*)d_in[i];
    a.out = (float*)d_out; a.ws = (unsigned char*)d_ws;
    for (int li = 0; li < N_LAUNCHES; ++li) {
        a.ph_lo = (N_LAUNCHES == 1) ? 0 : li; a.ph_hi = (N_LAUNCHES == 1) ? NPHASE : li + 1;
        hipLaunchKernelGGL(enc_fwd, dim3(grid), dim3(NWAVES * 64), LDS_BYTES, stream, a);
        const hipError_t le = hipPeekAtLastError();
        if (le != hipSuccess) { fprintf(stderr, "kernel_launch: launch %d failed: %s\n", li, hipGetErrorName(le)); break; }
    }
}
```
